# Optimizing an MI355X kernel written in HIP

```python
import jax, jax.numpy as jnp
from jax import lax
import numpy as np

D_MODEL = 1024
BATCH = 2
SEQ = 16384
DEPTH = 4

N_A_LAYERS = DEPTH // 2
N_B_LAYERS = DEPTH - N_A_LAYERS

POOL_WINDOWS = (2, 4, 8, 16)
N_POOL_GROUPS = len(POOL_WINDOWS)
POOL_GROUP = D_MODEL // N_POOL_GROUPS

N_HEADS = 16
QK_NOPE_DIM = 128
QK_ROPE_DIM = 64
QK_DIM = QK_NOPE_DIM + QK_ROPE_DIM
V_DIM = 128
Q_LORA_RANK = 256
KV_LORA_RANK = 128
ROPE_THETA = 10000.0
Q_BLOCK = 128

D_FF = 2816
RMS_EPS = 1e-6

kernel_name = "yoco_pool_mla_macaron_trunk"


def rmsnorm(x, g):
    xf = x.astype(jnp.float32)
    y = xf * lax.rsqrt(jnp.mean(xf * xf, axis=-1, keepdims=True) + RMS_EPS)
    return (y * g.astype(jnp.float32)).astype(x.dtype)


def swiglu(u, wg, wu, wd):
    return (jax.nn.silu(u @ wg) * (u @ wu)) @ wd


def rope_tables(seq):
    pos = jnp.arange(seq, dtype=jnp.float32)
    inv_freq = ROPE_THETA ** (-jnp.arange(0, QK_ROPE_DIM, 2, dtype=jnp.float32) / QK_ROPE_DIM)
    ang = pos[:, None] * inv_freq[None, :]
    return jnp.cos(ang), jnp.sin(ang)


def apply_rope(x, cos, sin):
    half = x.shape[-1] // 2
    x1, x2 = x[..., :half], x[..., half:]
    c, s = cos.astype(x.dtype), sin.astype(x.dtype)
    return jnp.concatenate([x1 * c - x2 * s, x1 * s + x2 * c], axis=-1)


def pool_mixer(u, w_groups, scale):
    B, S, D = u.shape
    uf = u.astype(jnp.float32)
    c = jnp.cumsum(uf, axis=1)
    count = jnp.arange(1, S + 1, dtype=jnp.float32)[None, :, None]
    outs = []
    for g, w in enumerate(POOL_WINDOWS):
        sl = slice(g * POOL_GROUP, (g + 1) * POOL_GROUP)
        cg = c[..., sl]
        lag = jnp.pad(cg, ((0, 0), (w, 0), (0, 0)))[:, :S]
        mean = (cg - lag) / jnp.minimum(count, float(w))
        outs.append(mean - uf[..., sl])
    y = jnp.stack(outs, axis=2).astype(u.dtype)
    z = jnp.einsum('bsgc,gcd->bsgd', y, w_groups).reshape(B, S, D)
    return z * scale


def mla_shared_kv(h, kv_in_norm, w_dkv, ckv_norm, w_uk, w_uv, cos, sin):
    u = rmsnorm(h, kv_in_norm)
    kv_a = u @ w_dkv
    c_kv = rmsnorm(kv_a[..., :KV_LORA_RANK], ckv_norm)
    k_rope = apply_rope(kv_a[..., KV_LORA_RANK:], cos[None], sin[None])
    k_nope = jnp.einsum('bsr,rhd->bshd', c_kv, w_uk)
    v = jnp.einsum('bsr,rhd->bshd', c_kv, w_uv)
    return k_nope, k_rope, v


def mla_attention(u, q_lora_norm, w_dq, w_uq, w_o, k_nope, k_rope, v, cos, sin):
    B, S, _ = u.shape
    cq = rmsnorm(u @ w_dq, q_lora_norm)
    q = jnp.einsum('bsr,rhd->bshd', cq, w_uq)
    q_nope = q[..., :QK_NOPE_DIM]
    q_rope = apply_rope(q[..., QK_NOPE_DIM:], cos[None, :, None], sin[None, :, None])
    nblk = S // Q_BLOCK
    qn = q_nope.reshape(B, nblk, Q_BLOCK, N_HEADS, QK_NOPE_DIM).transpose(1, 0, 2, 3, 4)
    qr = q_rope.reshape(B, nblk, Q_BLOCK, N_HEADS, QK_ROPE_DIM).transpose(1, 0, 2, 3, 4)
    scale = QK_DIM ** -0.5
    key_pos = jnp.arange(S)

    def block(args):
        i, qn_b, qr_b = args
        s = (jnp.einsum('bqhd,bkhd->bhqk', qn_b, k_nope)
             + jnp.einsum('bqhr,bkr->bhqk', qr_b, k_rope))
        s = s.astype(jnp.float32) * scale
        q_pos = i * Q_BLOCK + jnp.arange(Q_BLOCK)
        mask = key_pos[None, :] <= q_pos[:, None]
        s = jnp.where(mask[None, None], s, -jnp.inf)
        p = jax.nn.softmax(s, axis=-1).astype(v.dtype)
        return jnp.einsum('bhqk,bkhd->bqhd', p, v)

    o = lax.map(block, (jnp.arange(nblk), qn, qr))
    o = o.transpose(1, 0, 2, 3, 4).reshape(B, S, N_HEADS * V_DIM)
    return o @ w_o


def setup_inputs(seed: int = 0) -> dict:
    key = jax.random.key(seed)
    ks = jax.random.split(key, 32)
    f32 = jnp.float32

    def w(k, shape, fan_in):
        return jax.random.normal(k, shape, f32) * (fan_in ** -0.5)

    def gain(k, shape):
        return 1.0 + 0.02 * jax.random.normal(k, shape, f32)

    D, F, G, Dg = D_MODEL, D_FF, N_POOL_GROUPS, POOL_GROUP
    return {
        "x": jax.random.normal(ks[0], (BATCH, SEQ, D), f32),
        "ffn_pre_norm": gain(ks[1], (DEPTH, D)),
        "ffn_pre_wg": w(ks[2], (DEPTH, D, F), D),
        "ffn_pre_wu": w(ks[3], (DEPTH, D, F), D),
        "ffn_pre_wd": w(ks[4], (DEPTH, F, D), F),
        "mix_norm": gain(ks[5], (DEPTH, D)),
        "ffn_post_norm": gain(ks[6], (DEPTH, D)),
        "ffn_post_wg": w(ks[7], (DEPTH, D, F), D),
        "ffn_post_wu": w(ks[8], (DEPTH, D, F), D),
        "ffn_post_wd": w(ks[9], (DEPTH, F, D), F),
        "pool_w": w(ks[10], (N_A_LAYERS, G, Dg, Dg), Dg),
        "pool_scale": gain(ks[11], (N_A_LAYERS, D)),
        "kv_in_norm": gain(ks[12], (D,)),
        "w_dkv": w(ks[13], (D, KV_LORA_RANK + QK_ROPE_DIM), D),
        "ckv_norm": gain(ks[14], (KV_LORA_RANK,)),
        "w_uk": w(ks[15], (KV_LORA_RANK, N_HEADS, QK_NOPE_DIM), KV_LORA_RANK),
        "w_uv": w(ks[16], (KV_LORA_RANK, N_HEADS, V_DIM), KV_LORA_RANK),
        "q_lora_norm": gain(ks[17], (N_B_LAYERS, Q_LORA_RANK)),
        "w_dq": w(ks[18], (N_B_LAYERS, D, Q_LORA_RANK), D),
        "w_uq": w(ks[19], (N_B_LAYERS, Q_LORA_RANK, N_HEADS, QK_DIM), Q_LORA_RANK),
        "w_o": w(ks[20], (N_B_LAYERS, N_HEADS * V_DIM, D), N_HEADS * V_DIM),
        "final_norm": gain(ks[21], (D,)),
    }


def reference(x, ffn_pre_norm, ffn_pre_wg, ffn_pre_wu, ffn_pre_wd, mix_norm,
              ffn_post_norm, ffn_post_wg, ffn_post_wu, ffn_post_wd,
              pool_w, pool_scale, kv_in_norm, w_dkv, ckv_norm, w_uk, w_uv,
              q_lora_norm, w_dq, w_uq, w_o, final_norm):
    S = x.shape[1]
    cos, sin = rope_tables(S)
    h = x
    k_nope = k_rope = v = None
    for l in range(DEPTH):
        h = h + 0.5 * swiglu(rmsnorm(h, ffn_pre_norm[l]), ffn_pre_wg[l], ffn_pre_wu[l], ffn_pre_wd[l])
        u = rmsnorm(h, mix_norm[l])
        if l < N_A_LAYERS:
            h = h + pool_mixer(u, pool_w[l], pool_scale[l])
        else:
            j = l - N_A_LAYERS
            h = h + mla_attention(u, q_lora_norm[j], w_dq[j], w_uq[j], w_o[j],
                                  k_nope, k_rope, v, cos, sin)
        h = h + 0.5 * swiglu(rmsnorm(h, ffn_post_norm[l]), ffn_post_wg[l], ffn_post_wu[l], ffn_post_wd[l])
        if l == N_A_LAYERS - 1:
            k_nope, k_rope, v = mla_shared_kv(h, kv_in_norm, w_dkv, ckv_norm, w_uk, w_uv, cos, sin)
    return rmsnorm(h, final_norm)
```

```cpp
#include <hip/hip_runtime.h>
#include <hip/hip_cooperative_groups.h>
#include <cstdio>
#include <cstdint>
namespace cg = cooperative_groups;
namespace pg8 {
#define PG8_LAS __attribute__((address_space(3)))
typedef unsigned short bf16_t;
typedef short bf16x8 __attribute__((ext_vector_type(8)));
typedef float f32x4 __attribute__((ext_vector_type(4)));
typedef unsigned u32x4 __attribute__((ext_vector_type(4)));
constexpr int BM = 256, BK = 64, HALF = 128, HTB = HALF * BK * 2  , STAGE_BYTES = 8 * HTB, NXCD = 8, WGM = 8;

__host__ __device__ __forceinline__ int lds_byte(int r, int c) { const int st = (r >> 4) * 2 + (c >> 5), rr = r & 15, cc = c & 31, ob = rr * 64 + cc * 2; return st * 1024 + (ob ^ (((ob >> 9) & 1) << 5)); }
__host__ __device__ __forceinline__ void stage_rc(int b, int& R, int& C) { const int st = b / 1024, sb = b % 1024, swz = sb ^ (((sb >> 9) & 1) << 5); R = (st >> 1) * 16 + swz / 64; C = (st & 1) * 32 + (swz % 64) / 2; }
__host__ __device__ __forceinline__ int perm32(int rho) { const int n = rho >> 4, i = rho & 15; return 8 * (i >> 2) + 4 * n + (i & 3); }

struct Unit { int pm, pn; };
struct Gemm { const bf16_t* A; const bf16_t* Bt; int M, N, K; };

struct StaticOrder {
    int nM, nN, nwg, G, c;
    __host__ __device__ void init(int M, int N, int G_, int c_) { nM = M / BM; nN = N / BM; nwg = nM * nN; G = G_; c = c_; }
    __host__ __device__ bool next(int i, Unit& u) const {
        const long L = (long)i * G + c; if (L >= nwg) return false;
        int wgid = (int)L; { const int q = nwg / NXCD, r = nwg % NXCD, xcd = wgid % NXCD, off = wgid / NXCD; wgid = (xcd < r ? xcd * (q + 1) : r * (q + 1) + (xcd - r) * q) + off; }
        const int nig = WGM * nN, gid = wgid / nig, fm = gid * WGM, gsz = (nM - fm) < WGM ? (nM - fm) : WGM;
        u.pm = fm + ((wgid % nig) % gsz); u.pn = (wgid % nig) / gsz; return true;
    }
    __device__ __forceinline__ void a_ready(const Unit&) const {}
    __device__ __forceinline__ void done(const Unit&) const {}
};

template <class Epi, class Sched, bool ALIGN_EPI = false, bool SP2 = false>
__device__ __forceinline__ void gemm_phase(PG8_LAS unsigned char* lds, const Gemm g, const Sched& S, const Epi& E) {
    int tid_l = threadIdx.x; asm volatile("" : "+v"(tid_l));
    const int tid = tid_l, wid = __builtin_amdgcn_readfirstlane(tid >> 6), lane = tid & 63, wr = wid >> 2, wc = wid & 3, fr = lane & 15, fq = lane >> 4;
    const int K = g.K, nt = K / BK;
    unsigned voffA[2], voffB[2];
#pragma unroll
    for (int i = 0; i < 2; ++i) { int R, C; stage_rc(tid * 16 + i * 8192, R, C); const int Rb = Epi::PERM ? ((R & ~31) + perm32(R & 31)) : R;
        voffA[i] = (unsigned)(R * K + C) * 2u; voffB[i] = (unsigned)(Rb * K + C) * 2u; }
    const size_t kstep = (size_t)(BK * 2);
    const size_t hstep = (size_t)HALF * K * 2;
    const size_t tstep = 2 * hstep;
    const unsigned ldsw = (unsigned)wid * 1024u;
    const int aoff = lds_byte(wr * 64 + fr, fq * 8), boff = lds_byte(wc * 32 + fr, fq * 8);
#define PG8_SA(b, h) (((b) * 2 + (h)) * HTB)
#define PG8_SB(b, h) ((4 + (b) * 2 + (h)) * HTB)
#define PG8_STAGE(bufoff, gbase, voff) do { _Pragma("unroll") for (int _i = 0; _i < 2; ++_i) \
        __builtin_amdgcn_global_load_lds((const unsigned*)((const char*)(gbase) + (voff)[_i]), (PG8_LAS unsigned*)(lds + (bufoff) + ldsw + _i * 8192), 16, 0, 0); } while (0)
#define PG8_LDA(dst, b, h) do { _Pragma("unroll") for (int m = 0; m < 4; ++m) _Pragma("unroll") for (int k = 0; k < 2; ++k) dst[m][k] = *(const PG8_LAS bf16x8*)(lds + PG8_SA(b, h) + aoff + m * 2048 + k * 1024); } while (0)
#define PG8_LDB(dst, b, h) do { _Pragma("unroll") for (int n = 0; n < 2; ++n) _Pragma("unroll") for (int k = 0; k < 2; ++k) dst[n][k] = *(const PG8_LAS bf16x8*)(lds + PG8_SB(b, h) + boff + n * 2048 + k * 1024); } while (0)
#define PG8_MMA(ai, bj, At, Bt) do { __builtin_amdgcn_s_setprio(1); _Pragma("unroll") for (int m = 0; m < 4; ++m) _Pragma("unroll") for (int n = 0; n < 2; ++n) _Pragma("unroll") for (int k = 0; k < 2; ++k) \
        acc[ai][bj][m][n] = __builtin_amdgcn_mfma_f32_16x16x32_bf16(Bt[n][k], At[m][k], acc[ai][bj][m][n], 0, 0, 0); __builtin_amdgcn_s_setprio(0); } while (0)
#define PG8_WAIT_V(n) asm volatile("s_waitcnt vmcnt(" #n ")" ::: "memory")
#define PG8_WAIT_L(n) asm volatile("s_waitcnt lgkmcnt(" #n ")" ::: "memory")
#define PG8_BAR __builtin_amdgcn_s_barrier()
#define PG8_SCHED __builtin_amdgcn_sched_barrier(0)
    Unit cur, nxt; int ui = 0;
    if (!S.next(0, cur)) return;
    f32x4 acc[2][2][4][2];
#pragma unroll
    for (int a = 0; a < 2; ++a)
#pragma unroll
        for (int b = 0; b < 2; ++b)
#pragma unroll
            for (int m = 0; m < 4; ++m)
#pragma unroll
                for (int n = 0; n < 2; ++n) acc[a][b][m][n] = (f32x4){0.f, 0.f, 0.f, 0.f};
    bf16x8 At[4][2], B0[2][2], B1[2][2];
    const char* cA = (const char*)g.A + (size_t)cur.pm * tstep; const char* cB = (const char*)g.Bt + (size_t)cur.pn * tstep;
    S.a_ready(cur);
    if constexpr (SP2) {
        PG8_STAGE(PG8_SB(0, 0), cB, voffB); PG8_STAGE(PG8_SB(0, 1), cB + hstep, voffB); PG8_STAGE(PG8_SA(0, 0), cA, voffA); PG8_STAGE(PG8_SA(0, 1), cA + hstep, voffA);
        if (wr == 1) PG8_BAR;
        PG8_WAIT_V(2); PG8_BAR;
        PG8_STAGE(PG8_SB(1, 0), cB + kstep, voffB); PG8_STAGE(PG8_SA(1, 0), cA + kstep, voffA); PG8_STAGE(PG8_SB(1, 1), cB + hstep + kstep, voffB);
        PG8_WAIT_V(6); PG8_BAR;
    } else {
        PG8_STAGE(PG8_SB(0, 0), cB, voffB); PG8_STAGE(PG8_SA(0, 0), cA, voffA); PG8_STAGE(PG8_SB(0, 1), cB + hstep, voffB); PG8_STAGE(PG8_SA(0, 1), cA + hstep, voffA);
        if (wr == 1) PG8_BAR;
        PG8_WAIT_V(4); PG8_BAR;
        PG8_STAGE(PG8_SB(1, 0), cB + kstep, voffB); PG8_STAGE(PG8_SA(1, 0), cA + kstep, voffA); PG8_STAGE(PG8_SB(1, 1), cB + hstep + kstep, voffB);
        PG8_WAIT_V(6); PG8_BAR;
    }
    for (;;) {
        const bool has_next = S.next(ui + 1, nxt);
        const char* nA = has_next ? (const char*)g.A + (size_t)nxt.pm * tstep : cA; const char* nB = has_next ? (const char*)g.Bt + (size_t)nxt.pn * tstep : cB;
#pragma unroll 1
        for (int t = 0; t < nt; t += 2) {
            const bool last = (t == nt - 2);
            const char* a1 = cA + (size_t)(t + 1) * kstep;
            const char* a2 = last ? nA : cA + (size_t)(t + 2) * kstep; const char* b2 = last ? nB : cB + (size_t)(t + 2) * kstep;
            const char* a3 = a2 + kstep; const char* b3 = b2 + kstep;
            if (last && has_next) S.a_ready(nxt);
            if constexpr (SP2) {
            PG8_LDB(B0, 0, 0); PG8_LDB(B1, 0, 1); PG8_SCHED; PG8_LDA(At, 0, 0); PG8_STAGE(PG8_SA(1, 1), a1 + hstep, voffA);
            PG8_WAIT_V(8); PG8_WAIT_L(0); PG8_BAR; PG8_MMA(0, 0, At, B0); PG8_MMA(0, 1, At, B1); PG8_BAR; PG8_SCHED;
            PG8_LDA(At, 0, 1); PG8_STAGE(PG8_SB(0, 0), b2, voffB); PG8_STAGE(PG8_SB(0, 1), b2 + hstep, voffB); PG8_STAGE(PG8_SA(0, 0), a2, voffA);
            PG8_WAIT_V(8); PG8_WAIT_L(0); PG8_BAR; PG8_MMA(1, 0, At, B0); PG8_MMA(1, 1, At, B1); PG8_BAR; PG8_SCHED;
            PG8_LDB(B0, 1, 0); PG8_LDB(B1, 1, 1); PG8_SCHED; PG8_LDA(At, 1, 0); PG8_STAGE(PG8_SA(0, 1), a2 + hstep, voffA);
            PG8_WAIT_V(8); PG8_WAIT_L(0); PG8_BAR; PG8_MMA(0, 0, At, B0); PG8_MMA(0, 1, At, B1); PG8_BAR; PG8_SCHED;
            PG8_LDA(At, 1, 1); PG8_STAGE(PG8_SB(1, 0), b3, voffB); PG8_STAGE(PG8_SB(1, 1), b3 + hstep, voffB); PG8_STAGE(PG8_SA(1, 0), a3, voffA);
            PG8_WAIT_V(8); PG8_WAIT_L(0); PG8_BAR; PG8_MMA(1, 0, At, B0); PG8_MMA(1, 1, At, B1); PG8_BAR; PG8_SCHED;
            } else {
            PG8_LDB(B0, 0, 0); PG8_SCHED; PG8_LDA(At, 0, 0); PG8_STAGE(PG8_SA(1, 1), a1 + hstep, voffA);
            PG8_WAIT_L(8); PG8_BAR; PG8_WAIT_L(0); PG8_MMA(0, 0, At, B0); PG8_BAR; PG8_SCHED;
            PG8_LDB(B1, 0, 1); PG8_STAGE(PG8_SB(0, 0), b2, voffB);
            PG8_BAR; PG8_WAIT_L(0); PG8_MMA(0, 1, At, B1); PG8_BAR;
            PG8_LDA(At, 0, 1); PG8_STAGE(PG8_SA(0, 0), a2, voffA);
            PG8_BAR; PG8_WAIT_L(0); PG8_MMA(1, 0, At, B0); PG8_BAR; PG8_SCHED;
            PG8_STAGE(PG8_SB(0, 1), b2 + hstep, voffB);
            PG8_WAIT_V(6); PG8_BAR; PG8_MMA(1, 1, At, B1); PG8_BAR;
            PG8_LDB(B0, 1, 0); PG8_SCHED; PG8_LDA(At, 1, 0); PG8_STAGE(PG8_SA(0, 1), a2 + hstep, voffA);
            PG8_WAIT_L(8); PG8_BAR; PG8_WAIT_L(0); PG8_MMA(0, 0, At, B0); PG8_BAR; PG8_SCHED;
            PG8_LDB(B1, 1, 1); PG8_STAGE(PG8_SB(1, 0), b3, voffB);
            PG8_BAR; PG8_WAIT_L(0); PG8_MMA(0, 1, At, B1); PG8_BAR;
            PG8_LDA(At, 1, 1); PG8_STAGE(PG8_SA(1, 0), a3, voffA);
            PG8_BAR; PG8_WAIT_L(0); PG8_MMA(1, 0, At, B0); PG8_BAR; PG8_SCHED;
            PG8_STAGE(PG8_SB(1, 1), b3 + hstep, voffB);
            PG8_WAIT_V(6); PG8_BAR; PG8_MMA(1, 1, At, B1); PG8_BAR;
            }
        }
        if constexpr (ALIGN_EPI) { if (wr == 0) PG8_BAR; }
        if constexpr (!Epi::AFTER_DRAIN) { E(acc, cur, wr, wc, fr, fq); S.done(cur); }
        if (!has_next) break;
#pragma unroll
        for (int a = 0; a < 2; ++a)
#pragma unroll
            for (int b = 0; b < 2; ++b)
#pragma unroll
                for (int m = 0; m < 4; ++m)
#pragma unroll
                    for (int n = 0; n < 2; ++n) acc[a][b][m][n] = (f32x4){0.f, 0.f, 0.f, 0.f};
        cur = nxt; cA = nA; cB = nB; ++ui;
        if constexpr (ALIGN_EPI) { if (wr == 1) PG8_BAR; }
    }
    PG8_WAIT_V(0);
    if constexpr (!ALIGN_EPI) { if (wr == 0) PG8_BAR; }
    PG8_BAR;
    if constexpr (Epi::AFTER_DRAIN) { E.fused(acc, cur, wr, wc, fr, fq, lds, wid, lane); S.done(cur); }
#undef PG8_SA
#undef PG8_SB
#undef PG8_STAGE
#undef PG8_LDA
#undef PG8_LDB
#undef PG8_MMA
#undef PG8_WAIT_V
#undef PG8_WAIT_L
#undef PG8_BAR
#undef PG8_SCHED
}
}

#define LAS __attribute__((address_space(3)))
typedef unsigned short bf16_t;
typedef short bf16x8 __attribute__((ext_vector_type(8)));
typedef short s16x4 __attribute__((ext_vector_type(4)));
typedef float f32x4 __attribute__((ext_vector_type(4)));
typedef float f32x16 __attribute__((ext_vector_type(16)));
typedef unsigned u32x4 __attribute__((ext_vector_type(4)));
typedef unsigned u32x2 __attribute__((ext_vector_type(2)));

constexpr int D = 1024, NB = 2, S = 16384, T = NB * S, FF = 2816, NH = 16;
constexpr int NTHREADS = 512, NWAVES = 8;
constexpr int LDS_BYTES = 131072;
constexpr float RMS_EPS = 1e-6f;
constexpr float C2 = 0.07216878364870322f * 1.4426950408889634f;

constexpr size_t WS_R1 = 0;
constexpr size_t WS_R2 = 67108864;
constexpr size_t WS_RAW = WS_R2, WS_CQ = WS_R2 + 33554432;
constexpr size_t WS_R3 = 134217728;
constexpr size_t WS_KIMG = WS_R3 + 201326592;
constexpr size_t WS_COS = WS_KIMG + 12582912;
constexpr size_t WS_SIN = WS_COS + 2097152;
constexpr size_t WS_WGU = WS_SIN + 2097152;
constexpr size_t SZ_WGU = (size_t)5632 * 1024 * 2;
constexpr size_t WS_WD = WS_WGU + 8 * SZ_WGU;
constexpr size_t SZ_WD = (size_t)1024 * 2816 * 2;
constexpr size_t WS_WP = WS_WD + 8 * SZ_WD;
constexpr size_t SZ_WP = (size_t)1024 * 256 * 2;
constexpr size_t WS_WDKV = WS_WP + 2 * SZ_WP;
constexpr size_t WS_WDQ = WS_WDKV + 524288;
constexpr size_t WS_WUQ = WS_WDQ + 2 * 524288;
constexpr size_t SZ_WUQ = (size_t)3072 * 256 * 2;
constexpr size_t WS_WOV = WS_WUQ + 2 * SZ_WUQ;
constexpr size_t SZ_WOV = (size_t)1024 * 2048 * 2;
constexpr size_t WS_END = WS_WOV + 2 * SZ_WOV;

__device__ __forceinline__ unsigned pk2(float lo, float hi) {
    typedef float f2 __attribute__((ext_vector_type(2))); typedef __bf16 b2 __attribute__((ext_vector_type(2)));
    f2 v = {lo, hi}; b2 b = __builtin_convertvector(v, b2); return __builtin_bit_cast(unsigned, b);
}
__device__ __forceinline__ bf16_t bf1(float x) { return (bf16_t)(pk2(x, 0.f) & 0xffffu); }
__device__ __forceinline__ float wave_sum(float v) {
#pragma unroll
    for (int o = 1; o < 64; o <<= 1) v += __shfl_xor(v, o);
    return v;
}
__device__ __forceinline__ float dot4(f32x4 a, f32x4 b) { return (a.x * b.x + a.y * b.y) + (a.z * b.z + a.w * b.w); }

using pg8::Unit;
struct EpiSwiGLU {
    static constexpr bool PERM = true, AFTER_DRAIN = false;
    bf16_t* O;
    __device__ __forceinline__ void operator()(const f32x4 (&acc)[2][2][4][2], const Unit& u, int wr, int wc, int fr, int fq) const {
        const int row0 = u.pm * 256 + wr * 64 + fr, col0 = u.pn * 128 + wc * 32 + 8 * fq;
#pragma unroll
        for (int ai = 0; ai < 2; ++ai)
#pragma unroll
            for (int m = 0; m < 4; ++m) {
                float r[8];
#pragma unroll
                for (int n = 0; n < 2; ++n)
#pragma unroll
                    for (int j = 0; j < 4; ++j) {
                        const float g = acc[ai][0][m][n][j], up = acc[ai][1][m][n][j];
                        const float e = __builtin_amdgcn_exp2f(-1.4426950408889634f * g);
                        r[4 * n + j] = g * __builtin_amdgcn_rcpf(1.0f + e) * up;
                    }
                u32x4 w; w.x = pk2(r[0], r[1]); w.y = pk2(r[2], r[3]); w.z = pk2(r[4], r[5]); w.w = pk2(r[6], r[7]);
                *(u32x4*)(O + (size_t)(row0 + ai * 128 + m * 16) * FF + col0) = w;
            }
    }
};
struct EpiResid {
    static constexpr bool PERM = false, AFTER_DRAIN = false;
    const float* base; float* out; const float* scale; float alpha; int pm_mask;
    __device__ __forceinline__ void operator()(const f32x4 (&acc)[2][2][4][2], const Unit& u, int wr, int wc, int fr, int fq) const {
        const int row0 = (u.pm & pm_mask) * 256 + wr * 64 + fr, col0 = u.pn * 256 + wc * 32 + 4 * fq;
        f32x4 sc[2][2];
#pragma unroll
        for (int bj = 0; bj < 2; ++bj)
#pragma unroll
            for (int n = 0; n < 2; ++n) { sc[bj][n] = (f32x4){alpha, alpha, alpha, alpha}; if (scale) sc[bj][n] = sc[bj][n] * *(const f32x4*)(scale + col0 + bj * 128 + n * 16); }
#pragma unroll
        for (int ai = 0; ai < 2; ++ai)
#pragma unroll
            for (int m = 0; m < 4; ++m) {
                const size_t off = (size_t)(row0 + ai * 128 + m * 16) * D + col0;
#pragma unroll
                for (int bj = 0; bj < 2; ++bj)
#pragma unroll
                    for (int n = 0; n < 2; ++n) {
                        const f32x4 b = *(const f32x4*)(base + off + bj * 128 + n * 16);
                        *(f32x4*)(out + off + bj * 128 + n * 16) = b + acc[ai][bj][m][n] * sc[bj][n];
                    }
                if (m & 1) asm volatile("" ::: "memory");
            }
    }
};
__device__ __forceinline__ f32x4 bf_lo4(unsigned a, unsigned b) { return (f32x4){__uint_as_float(a << 16), __uint_as_float(a & 0xffff0000u), __uint_as_float(b << 16), __uint_as_float(b & 0xffff0000u)}; }
template <bool HALF_STEP, int PM_MASK> struct EpiResidB {
    static constexpr bool PERM = true, AFTER_DRAIN = false;
    const float* base32; const bf16_t* base16; bf16_t* out; const float* scale;
    __device__ __forceinline__ void operator()(const f32x4 (&acc)[2][2][4][2], const Unit& u, int wr, int wc, int fr, int fq) const {
        constexpr float alpha = HALF_STEP ? 0.5f : 1.0f;
        const int row0 = (u.pm & PM_MASK) * 256 + wr * 64 + fr, col0 = u.pn * 256 + wc * 32 + 8 * fq;
        f32x4 sc[2][2];
#pragma unroll
        for (int bj = 0; bj < 2; ++bj)
#pragma unroll
            for (int n = 0; n < 2; ++n) { sc[bj][n] = (f32x4){alpha, alpha, alpha, alpha}; if (scale) sc[bj][n] = sc[bj][n] * *(const f32x4*)(scale + col0 + bj * 128 + 4 * n); }
#pragma unroll
        for (int ai = 0; ai < 2; ++ai)
#pragma unroll
            for (int m = 0; m < 4; ++m) {
                const size_t off = (size_t)(row0 + ai * 128 + m * 16) * D + col0;
#pragma unroll
                for (int bj = 0; bj < 2; ++bj) {
                    f32x4 b0, b1;
                    if (base32) { b0 = *(const f32x4*)(base32 + off + bj * 128); b1 = *(const f32x4*)(base32 + off + bj * 128 + 4); }
                    else { const u32x4 w = *(const u32x4*)(base16 + off + bj * 128); b0 = bf_lo4(w.x, w.y); b1 = bf_lo4(w.z, w.w); }
                    const f32x4 v0 = b0 + acc[ai][bj][m][0] * sc[bj][0], v1 = b1 + acc[ai][bj][m][1] * sc[bj][1];
                    u32x4 o; o.x = pk2(v0.x, v0.y); o.y = pk2(v0.z, v0.w); o.z = pk2(v1.x, v1.y); o.w = pk2(v1.z, v1.w);
                    *(u32x4*)(out + off + bj * 128) = o;
                }
                if (m & 1) asm volatile("" ::: "memory");
            }
    }
};
struct EpiF32 {
    static constexpr bool PERM = false, AFTER_DRAIN = false;
    float* O;
    __device__ __forceinline__ void operator()(const f32x4 (&acc)[2][2][4][2], const Unit& u, int wr, int wc, int fr, int fq) const {
        const int row0 = u.pm * 256 + wr * 64 + fr, col0 = wc * 32 + 4 * fq;
#pragma unroll
        for (int ai = 0; ai < 2; ++ai)
#pragma unroll
            for (int m = 0; m < 4; ++m)
#pragma unroll
                for (int bj = 0; bj < 2; ++bj)
#pragma unroll
                    for (int n = 0; n < 2; ++n) *(f32x4*)(O + (size_t)(row0 + ai * 128 + m * 16) * 256 + col0 + bj * 128 + n * 16) = acc[ai][bj][m][n];
    }
};
struct EpiQN {
    static constexpr bool PERM = true, AFTER_DRAIN = false;
    bf16_t* Q;
    __device__ __forceinline__ void operator()(const f32x4 (&acc)[2][2][4][2], const Unit& u, int wr, int wc, int fr, int fq) const {
        const int row0 = u.pm * 256 + wr * 64 + fr;
#pragma unroll
        for (int ai = 0; ai < 2; ++ai)
#pragma unroll
            for (int m = 0; m < 4; ++m)
#pragma unroll
                for (int bj = 0; bj < 2; ++bj) {
                    const f32x4 v0 = acc[ai][bj][m][0] * C2, v1 = acc[ai][bj][m][1] * C2;
                    u32x4 w; w.x = pk2(v0.x, v0.y); w.y = pk2(v0.z, v0.w); w.z = pk2(v1.x, v1.y); w.w = pk2(v1.z, v1.w);
                    *(u32x4*)(Q + (size_t)(row0 + ai * 128 + m * 16) * 3072 + (2 * u.pn + bj) * 192 + wc * 32 + 8 * fq) = w;
                }
    }
};
struct EpiQR {
    static constexpr bool PERM = true, AFTER_DRAIN = false;
    bf16_t* Q; const float* COS; const float* SIN;
    __device__ __forceinline__ void operator()(const f32x4 (&acc)[2][2][4][2], const Unit& u, int wr, int wc, int fr, int fq) const {
        const int row0 = u.pm * 256 + wr * 64 + fr;
        const int head = 4 * u.pn + wc, i0 = 8 * fq;
#pragma unroll
        for (int ai = 0; ai < 2; ++ai)
#pragma unroll
            for (int m = 0; m < 4; ++m) {
                const int row = row0 + ai * 128 + m * 16, pos = row & (S - 1);
                const f32x4 c0 = *(const f32x4*)(COS + pos * 32 + i0), c1 = *(const f32x4*)(COS + pos * 32 + i0 + 4);
                const f32x4 s0 = *(const f32x4*)(SIN + pos * 32 + i0), s1 = *(const f32x4*)(SIN + pos * 32 + i0 + 4);
                const f32x4 x1a = acc[ai][0][m][0], x1b = acc[ai][0][m][1], x2a = acc[ai][1][m][0], x2b = acc[ai][1][m][1];
                const f32x4 o1a = (x1a * c0 - x2a * s0) * C2, o1b = (x1b * c1 - x2b * s1) * C2;
                const f32x4 o2a = (x1a * s0 + x2a * c0) * C2, o2b = (x1b * s1 + x2b * c1) * C2;
                bf16_t* qp = Q + (size_t)row * 3072 + head * 192 + 128 + i0;
                u32x4 w; w.x = pk2(o1a.x, o1a.y); w.y = pk2(o1a.z, o1a.w); w.z = pk2(o1b.x, o1b.y); w.w = pk2(o1b.z, o1b.w);
                *(u32x4*)qp = w;
                w.x = pk2(o2a.x, o2a.y); w.y = pk2(o2a.z, o2a.w); w.z = pk2(o2b.x, o2b.y); w.w = pk2(o2b.z, o2b.w);
                *(u32x4*)(qp + 32) = w;
                asm volatile("" ::: "memory");
            }
    }
};
struct PoolOrder {
    int G, c;
    __device__ __forceinline__ bool next(int i, Unit& u) const { const int L = i * G + c; if (L >= 4 * (T / 256)) return false; u.pm = L; u.pn = L >> 7; return true; }
    __device__ __forceinline__ void a_ready(const Unit&) const {}
    __device__ __forceinline__ void done(const Unit&) const {}
};

__device__ __forceinline__ void transpose_item(const float* __restrict__ W, int ldw, bf16_t* WT, int ldt, LAS float* scr, int k0, int n0, int r0, int lane) {
#pragma unroll 8
    for (int i = 0; i < 32; ++i) { const int kk = 2 * i + (lane >> 5); scr[kk * 33 + (lane & 31)] = W[(size_t)(k0 + kk) * ldw + n0 + (lane & 31)]; }
    asm volatile("s_waitcnt lgkmcnt(0)" ::: "memory");
    const int c = lane & 7;
#pragma unroll
    for (int j = 0; j < 4; ++j) {
        const int n = (lane >> 3) + 8 * j; const LAS float* s = scr + (8 * c) * 33 + n;
        u32x4 o; o.x = pk2(s[0 * 33], s[1 * 33]); o.y = pk2(s[2 * 33], s[3 * 33]); o.z = pk2(s[4 * 33], s[5 * 33]); o.w = pk2(s[6 * 33], s[7 * 33]);
        *(u32x4*)(WT + (size_t)(r0 + n) * ldt + k0 + 8 * c) = o;
    }
    asm volatile("s_waitcnt lgkmcnt(0)" ::: "memory");
}

__device__ __forceinline__ void norm_phase(const float* src, const float* gain, bf16_t* dst, int gw, int NGW, int lane) {
    f32x4 g[4];
#pragma unroll
    for (int j = 0; j < 4; ++j) g[j] = ((const f32x4*)gain)[lane + 64 * j];
    for (int m = gw; m < T; m += NGW) {
        const f32x4* xr = (const f32x4*)(src + (size_t)m * D) + lane;
        f32x4 v[4]; float s = 0.f;
#pragma unroll
        for (int j = 0; j < 4; ++j) { v[j] = xr[64 * j]; s += dot4(v[j], v[j]); }
        const float rstd = 1.0f / sqrtf(wave_sum(s) * (1.0f / D) + RMS_EPS);
        u32x2* o8 = (u32x2*)(dst + (size_t)m * D) + lane;
#pragma unroll
        for (int j = 0; j < 4; ++j) { const f32x4 o = v[j] * rstd * g[j]; u32x2 w; w.x = pk2(o.x, o.y); w.y = pk2(o.z, o.w); o8[64 * j] = w; }
    }
}
__device__ __forceinline__ void norm_phase16(const bf16_t* src, const float* gain, bf16_t* dst, int gw, int NGW, int lane) {
    f32x4 g[4];
    g[0] = *(const f32x4*)(gain + 8 * lane); g[1] = *(const f32x4*)(gain + 8 * lane + 4); g[2] = *(const f32x4*)(gain + 512 + 8 * lane); g[3] = *(const f32x4*)(gain + 512 + 8 * lane + 4);
    for (int m0 = gw; m0 < T; m0 += 4 * NGW) {
        u32x4 wa[4], wb[4];
#pragma unroll
        for (int q = 0; q < 4; ++q) { const int m = m0 + q * NGW; if (m < T) { wa[q] = *(const u32x4*)(src + (size_t)m * D + 8 * lane); wb[q] = *(const u32x4*)(src + (size_t)m * D + 512 + 8 * lane); } }
#pragma unroll
        for (int q = 0; q < 4; ++q) { const int m = m0 + q * NGW; if (m < T) {
            f32x4 v[4]; v[0] = bf_lo4(wa[q].x, wa[q].y); v[1] = bf_lo4(wa[q].z, wa[q].w); v[2] = bf_lo4(wb[q].x, wb[q].y); v[3] = bf_lo4(wb[q].z, wb[q].w);
            float s = 0.f;
#pragma unroll
            for (int j = 0; j < 4; ++j) s += dot4(v[j], v[j]);
            const float rstd = 1.0f / sqrtf(wave_sum(s) * (1.0f / D) + RMS_EPS);
            u32x4 oa, ob;
            { const f32x4 a = v[0] * rstd * g[0], b = v[1] * rstd * g[1]; oa.x = pk2(a.x, a.y); oa.y = pk2(a.z, a.w); oa.z = pk2(b.x, b.y); oa.w = pk2(b.z, b.w); }
            { const f32x4 a = v[2] * rstd * g[2], b = v[3] * rstd * g[3]; ob.x = pk2(a.x, a.y); ob.y = pk2(a.z, a.w); ob.z = pk2(b.x, b.y); ob.w = pk2(b.z, b.w); }
            *(u32x4*)(dst + (size_t)m * D + 8 * lane) = oa; *(u32x4*)(dst + (size_t)m * D + 512 + 8 * lane) = ob; } }
    }
}
__device__ __forceinline__ void final_norm_phase(float* io, const float* gain, int gw, int NGW, int lane) {
    f32x4 g[4];
#pragma unroll
    for (int j = 0; j < 4; ++j) g[j] = ((const f32x4*)gain)[lane + 64 * j];
    for (int m = gw; m < T; m += NGW) {
        f32x4* xr = (f32x4*)(io + (size_t)m * D) + lane;
        f32x4 v[4]; float s = 0.f;
#pragma unroll
        for (int j = 0; j < 4; ++j) { v[j] = xr[64 * j]; s += dot4(v[j], v[j]); }
        const float rstd = 1.0f / sqrtf(wave_sum(s) * (1.0f / D) + RMS_EPS);
#pragma unroll
        for (int j = 0; j < 4; ++j) xr[64 * j] = v[j] * rstd * g[j];
    }
}
__device__ __forceinline__ void cq_norm_phase(const float* RAW, const float* gain, bf16_t* CQ, int gw, int NGW, int lane) {
    const f32x4 g = ((const f32x4*)gain)[lane];
    for (int m = gw; m < T; m += NGW) {
        const f32x4 v = ((const f32x4*)(RAW + (size_t)m * 256))[lane];
        const float rstd = 1.0f / sqrtf(wave_sum(dot4(v, v)) * (1.0f / 256.0f) + RMS_EPS);
        const f32x4 o = v * rstd * g; u32x2 w; w.x = pk2(o.x, o.y); w.y = pk2(o.z, o.w);
        ((u32x2*)(CQ + (size_t)m * 256))[lane] = w;
    }
}
__device__ __forceinline__ unsigned off_b(unsigned row, unsigned ch) { return 2048u * (row >> 3) + 512u * (ch >> 2) + 64u * (row & 7) + 16u * ((ch & 3) ^ ((row >> 2) & 3)); }
__device__ __forceinline__ unsigned off_r(unsigned row, unsigned ch) { return 8192u + 128u * row + 16u * (ch ^ ((row >> 1) & 7)); }
__device__ __forceinline__ void kv_prep_phase(const float* RAW, const float* ckv_gain, const float* COS, const float* SIN, unsigned char* KIMG, int gw, int NGW, int lane) {
    const f32x4 g = ((const f32x4*)ckv_gain)[lane & 31];
    for (int m = gw; m < T; m += NGW) {
        const f32x4 v = ((const f32x4*)(RAW + (size_t)m * 256))[lane];
        const float ss = wave_sum(lane < 32 ? dot4(v, v) : 0.f);
        const float rstd = 1.0f / sqrtf(ss * (1.0f / 128.0f) + RMS_EPS);
        const int tt = m & (S - 1), b = m >> 14, tile = tt >> 6, kb = (tt >> 5) & 1, row = tt & 31;
        unsigned char* base = KIMG + ((size_t)(b * 256 + tile)) * 24576 + kb * 12288;
        f32x4 other; other.x = __shfl_xor(v.x, 8); other.y = __shfl_xor(v.y, 8); other.z = __shfl_xor(v.z, 8); other.w = __shfl_xor(v.w, 8);
        if (lane < 32) {
            const f32x4 o = v * rstd * g; u32x2 w; w.x = pk2(o.x, o.y); w.y = pk2(o.z, o.w);
            *(u32x2*)(base + off_b(row, lane >> 1) + 8 * (lane & 1)) = w;
        } else if (lane < 48) {
            const int i0 = 4 * (lane & 7); const bool second = lane >= 40;
            const f32x4 c = *(const f32x4*)(COS + tt * 32 + i0), s = *(const f32x4*)(SIN + tt * 32 + i0);
            const f32x4 x1 = second ? other : v, x2 = second ? v : other;
            const f32x4 o = second ? (x1 * s + x2 * c) : (x1 * c - x2 * s);
            const int cr = (second ? 32 : 0) + i0;
            u32x2 w; w.x = pk2(o.x, o.y); w.y = pk2(o.z, o.w);
            *(u32x2*)(base + off_r(row, cr >> 3) + 8 * ((cr >> 2) & 1)) = w;
        }
    }
}
template <int W> __device__ __forceinline__ void pool_rows(const bf16_t* H, const float* gain, bf16_t* Y, const LAS float* rs, int t0, int bstart, int g, int oct, int tq) {
    constexpr int NR = 16 + W - 1;
    const int c0 = g * 256 + oct * 8, tb = t0 + 16 * tq;
    u32x4 raw[NR];
#pragma unroll
    for (int k = 0; k < NR; ++k) { const int t = tb - (W - 1) + k; raw[k] = (t >= bstart) ? *(const u32x4*)(H + (size_t)t * D + c0) : (u32x4){0u, 0u, 0u, 0u}; }
    const f32x4 g0 = *(const f32x4*)(gain + c0), g1 = *(const f32x4*)(gain + c0 + 4);
    f32x4 s0 = {0.f, 0.f, 0.f, 0.f}, s1 = {0.f, 0.f, 0.f, 0.f};
#pragma unroll
    for (int k = 0; k < NR; ++k) {
        const int t = tb - (W - 1) + k;
        const float r = rs[t - (t0 - 16)];
        const f32x4 u0 = bf_lo4(raw[k].x, raw[k].y) * r * g0, u1 = bf_lo4(raw[k].z, raw[k].w) * r * g1;
        s0 = s0 + u0; s1 = s1 + u1;
        if (k >= W) { const float ro = rs[t - W - (t0 - 16)];
            u32x4 old = raw[k - W]; asm volatile("" : "+v"(old));
            s0 = s0 - bf_lo4(old.x, old.y) * ro * g0; s1 = s1 - bf_lo4(old.z, old.w) * ro * g1; }
        if (k >= W - 1) {
            const int cnt = min(t - bstart + 1, W); const float ic = 1.0f / (float)cnt;
            const f32x4 y0 = s0 * ic - u0, y1 = s1 * ic - u1;
            u32x4 w; w.x = pk2(y0.x, y0.y); w.y = pk2(y0.z, y0.w); w.z = pk2(y1.x, y1.y); w.w = pk2(y1.z, y1.w);
            *(u32x4*)(Y + ((size_t)g * T + t) * 256 + oct * 8) = w;
        }
    }
}
__device__ __forceinline__ void pool_y_phase(const bf16_t* H, const float* gain, bf16_t* Y, LAS float* rs, int bid, int G, int tid, int lane, int wave) {
    for (int chunk = bid; chunk < T / 64; chunk += G) {
        const int t0 = chunk * 64, bstart = (t0 >> 14) << 14;
        for (int rr = wave; rr < 80; rr += NWAVES) {
            const int t = t0 - 16 + rr;
            float rstd = 0.f;
            if (t >= bstart) {
                const u32x4 wa = *(const u32x4*)(H + (size_t)t * D + 8 * lane), wb = *(const u32x4*)(H + (size_t)t * D + 512 + 8 * lane);
                const f32x4 a = bf_lo4(wa.x, wa.y), b = bf_lo4(wa.z, wa.w), c = bf_lo4(wb.x, wb.y), d = bf_lo4(wb.z, wb.w);
                rstd = 1.0f / sqrtf(wave_sum((dot4(a, a) + dot4(b, b)) + (dot4(c, c) + dot4(d, d))) * (1.0f / D) + RMS_EPS);
            }
            if (lane == 0) rs[rr] = rstd;
        }
        __syncthreads();
        {
            const int g = wave >> 1, idx = (wave & 1) * 64 + lane, oct = idx & 31, tq = idx >> 5;
            if (g == 0) pool_rows<2>(H, gain, Y, rs, t0, bstart, 0, oct, tq);
            else if (g == 1) pool_rows<4>(H, gain, Y, rs, t0, bstart, 1, oct, tq);
            else if (g == 2) pool_rows<8>(H, gain, Y, rs, t0, bstart, 2, oct, tq);
            else pool_rows<16>(H, gain, Y, rs, t0, bstart, 3, oct, tq);
        }
        __syncthreads();
    }
}

__device__ __forceinline__ int crow(int r, int hi) { return (r & 3) + 8 * (r >> 2) + 4 * hi; }
__device__ __forceinline__ bf16x8 pack8(const f32x16& x, int s) {
    u32x4 p; p.x = pk2(x[8 * s], x[8 * s + 1]); p.y = pk2(x[8 * s + 2], x[8 * s + 3]); p.z = pk2(x[8 * s + 4], x[8 * s + 5]); p.w = pk2(x[8 * s + 6], x[8 * s + 7]);
    return __builtin_bit_cast(bf16x8, p);
}
__device__ __forceinline__ void glds16(const void* gsrc, unsigned lds_dst) { unsigned keep;
    asm volatile("s_mov_b32 %0, m0\n\ts_mov_b32 m0, %2\n\ts_nop 0\n\tglobal_load_lds_dwordx4 %1, off\n\ts_mov_b32 m0, %0" : "=&s"(keep) : "v"(gsrc), "s"(lds_dst) : "memory"); }
#define SGB_VMASK 0x402
#define SCHEDB() __builtin_amdgcn_sched_barrier(0)
#define SGB_MV(nm, nv) do { _Pragma("unroll") for (int g_ = 0; g_ < (nm); ++g_) { __builtin_amdgcn_sched_group_barrier(0x008, 1, 0); __builtin_amdgcn_sched_group_barrier(SGB_VMASK, (nv), 0); } } while (0)
#define H_LOAD(kb, g, dst) do { _Pragma("unroll") for (int e_ = 0; e_ < 4; ++e_) { const int s_ = 4 * (g) + e_; \
        if (s_ < 8) dst[e_] = *(const LAS bf16x8*)(lds + ka[s_ & 1] + (512 * (s_ >> 1) + 12288 * (kb))); \
        else        dst[e_] = *(const LAS bf16x8*)(lds + kr[s_ - 8] + (8192 + 12288 * (kb))); } } while (0)
#define H_MMA(S, g, src) do { _Pragma("unroll") for (int e_ = 0; e_ < 4; ++e_) S = __builtin_amdgcn_mfma_f32_32x32x16_bf16(src[e_], qf[4 * (g) + e_], S, 0, 0, 0); } while (0)
#define HV_LOAD(h, c, dst) do { _Pragma("unroll") for (int k_ = 0; k_ < 2; ++k_) { \
        dst[2 * k_] = __builtin_amdgcn_ds_read_tr16_b64_v4i16((LAS s16x4*)(lds + va[0] + ((h) * 12288 + k_ * 4096 + 512 * (c)))); \
        dst[2 * k_ + 1] = __builtin_amdgcn_ds_read_tr16_b64_v4i16((LAS s16x4*)(lds + va[1] + ((h) * 12288 + k_ * 4096 + 2048 + 512 * (c)))); } } while (0)
#define HV_MMA(h, c, src) do { _Pragma("unroll") for (int k_ = 0; k_ < 2; ++k_) { \
        const bf16x8 vf_ = __builtin_shufflevector(src[2 * k_], src[2 * k_ + 1], 0, 1, 2, 3, 4, 5, 6, 7); \
        o[c] = __builtin_amdgcn_mfma_f32_32x32x16_bf16(vf_, pf[2 * (h) + k_], o[c], 0, 0, 0); } } while (0)
#define EXP8_PIN(S, lo) do { float e_[8]; _Pragma("unroll") for (int r_ = 0; r_ < 8; ++r_) e_[r_] = __builtin_amdgcn_exp2f(S[(lo) + r_]); \
        asm volatile("" : "+v"(e_[0]), "+v"(e_[1]), "+v"(e_[2]), "+v"(e_[3]), "+v"(e_[4]), "+v"(e_[5]), "+v"(e_[6]), "+v"(e_[7])); \
        _Pragma("unroll") for (int r_ = 0; r_ < 8; ++r_) S[(lo) + r_] = e_[r_]; } while (0)
__device__ __forceinline__ float half_max(const f32x16& x) {
    float m = fmaxf(fmaxf(x[0], x[1]), x[2]);
#pragma unroll
    for (int r = 3; r < 15; r += 2) m = fmaxf(fmaxf(m, x[r]), x[r + 1]);
    m = fmaxf(m, x[15]);
    return fmaxf(m, __shfl_xor(m, 32));
}
__device__ __forceinline__ bf16x8 scale_pf(bf16x8 p, float sc) {
    u32x4 u = __builtin_bit_cast(u32x4, p); u32x4 r;
#pragma unroll
    for (int i = 0; i < 4; ++i) { const float lo = __uint_as_float(u[i] << 16) * sc, hi = __uint_as_float(u[i] & 0xffff0000u) * sc; r[i] = pk2(lo, hi); }
    return __builtin_bit_cast(bf16x8, r);
}
__device__ __forceinline__ void attn_tile2(LAS unsigned char* lds, const bf16x8 (&qf)[12], f32x16& negm, f32x16 (&o)[4], float& mref, float& lsum,
                                           const unsigned (&ka)[2], const unsigned (&kr)[4], const unsigned (&va)[2], bool first, bool last, int qpos, int kb0) {
    f32x16 s0, s1;
    bf16x8 A0[4], A1[4], pf[4];
    s16x4 V0[4], V1[4];
    H_LOAD(0, 0, A0); H_LOAD(0, 1, A1);
    __builtin_amdgcn_s_setprio(1);
    SCHEDB();
    s0 = __builtin_amdgcn_mfma_f32_32x32x16_bf16(A0[0], qf[0], negm, 0, 0, 0);
#pragma unroll
    for (int e = 1; e < 4; ++e) s0 = __builtin_amdgcn_mfma_f32_32x32x16_bf16(A0[e], qf[e], s0, 0, 0, 0);
    SCHEDB();
    H_LOAD(0, 2, A0); SCHEDB();
    H_MMA(s0, 1, A1); SCHEDB();
    H_LOAD(1, 0, A1); SCHEDB();
    H_MMA(s0, 2, A0); SCHEDB();
    __builtin_amdgcn_s_setprio(0);
    H_LOAD(1, 1, A0);
    if (last) {
        int ln = (int)__builtin_amdgcn_mbcnt_hi(~0u, __builtin_amdgcn_mbcnt_lo(~0u, 0u)); asm volatile("" : "+v"(ln));
        const int qp_ = qpos + (ln & 31), hi_ = ln >> 5;
#pragma unroll
        for (int r = 0; r < 16; ++r) { const int key = kb0 + crow(r, hi_); if (key > qp_) s0[r] = -INFINITY; }
    }
    {
        const float mx = half_max(s0);
        const bool need = (mx > 8.0f) || first;
        if (__builtin_amdgcn_ballot_w64(need) != 0ull) {
            const float dl = need ? mx : 0.f;
            const float sc = first ? 0.f : __builtin_amdgcn_exp2f(-dl);
            mref += dl; lsum *= sc;
#pragma unroll
            for (int r = 0; r < 16; ++r) { s0[r] -= dl; negm[r] = -mref; }
#pragma unroll
            for (int c = 0; c < 4; ++c)
#pragma unroll
                for (int r = 0; r < 16; ++r) o[c][r] *= sc;
        }
    }
    SCHEDB();
    __builtin_amdgcn_s_setprio(1);
    s1 = __builtin_amdgcn_mfma_f32_32x32x16_bf16(A1[0], qf[0], negm, 0, 0, 0);
#pragma unroll
    for (int e = 1; e < 4; ++e) s1 = __builtin_amdgcn_mfma_f32_32x32x16_bf16(A1[e], qf[e], s1, 0, 0, 0);
    EXP8_PIN(s0, 0);
    SGB_MV(4, 2);
    SCHEDB();
    H_LOAD(1, 2, A1); SCHEDB();
    H_MMA(s1, 1, A0);
    EXP8_PIN(s0, 8);
    SGB_MV(4, 2);
    SCHEDB();
    HV_LOAD(0, 0, V0); SCHEDB();
    H_MMA(s1, 2, A1);
    { float rs = 0.f;
#pragma unroll
      for (int r = 0; r < 16; ++r) rs += s0[r];
      lsum += rs; }
    pf[0] = pack8(s0, 0); pf[1] = pack8(s0, 1);
    asm volatile("" : "+v"(lsum));
    SGB_MV(4, 6);
    SCHEDB();
    __builtin_amdgcn_s_setprio(0);
    if (last) {
        int ln = (int)__builtin_amdgcn_mbcnt_hi(~0u, __builtin_amdgcn_mbcnt_lo(~0u, 0u)); asm volatile("" : "+v"(ln));
        const int qp_ = qpos + (ln & 31), hi_ = ln >> 5;
#pragma unroll
        for (int r = 0; r < 16; ++r) { const int key = kb0 + 32 + crow(r, hi_); if (key > qp_) s1[r] = -INFINITY; }
    }
    {
        const float mx = half_max(s1);
        const bool need = mx > 8.0f;
        if (__builtin_amdgcn_ballot_w64(need) != 0ull) {
            const float dl = need ? mx : 0.f;
            const float sc = __builtin_amdgcn_exp2f(-dl);
            mref += dl; lsum *= sc;
#pragma unroll
            for (int r = 0; r < 16; ++r) { s1[r] -= dl; negm[r] = -mref; }
#pragma unroll
            for (int c = 0; c < 4; ++c)
#pragma unroll
                for (int r = 0; r < 16; ++r) o[c][r] *= sc;
            pf[0] = scale_pf(pf[0], sc); pf[1] = scale_pf(pf[1], sc);
        }
    }
    SCHEDB();
    __builtin_amdgcn_s_setprio(1);
    HV_LOAD(0, 1, V1); SCHEDB();
    HV_MMA(0, 0, V0);
#pragma unroll
    for (int r = 0; r < 6; ++r) s1[r] = __builtin_amdgcn_exp2f(s1[r]);
    SGB_MV(2, 3);
    SCHEDB();
    HV_LOAD(0, 2, V0); SCHEDB();
    HV_MMA(0, 1, V1);
#pragma unroll
    for (int r = 6; r < 12; ++r) s1[r] = __builtin_amdgcn_exp2f(s1[r]);
    SGB_MV(2, 3);
    SCHEDB();
    HV_LOAD(0, 3, V1); SCHEDB();
    HV_MMA(0, 2, V0);
#pragma unroll
    for (int r = 12; r < 16; ++r) s1[r] = __builtin_amdgcn_exp2f(s1[r]);
    SGB_MV(2, 2);
    SCHEDB();
    HV_LOAD(1, 0, V0); SCHEDB();
    HV_MMA(0, 3, V1);
    { float rs = 0.f;
#pragma unroll
      for (int r = 0; r < 16; ++r) rs += s1[r];
      lsum += rs; }
    pf[2] = pack8(s1, 0); pf[3] = pack8(s1, 1);
    SGB_MV(2, 12);
    SCHEDB();
    HV_LOAD(1, 1, V1); SCHEDB(); HV_MMA(1, 0, V0); SCHEDB();
    HV_LOAD(1, 2, V0); SCHEDB(); HV_MMA(1, 1, V1); SCHEDB();
    HV_LOAD(1, 3, V1); SCHEDB(); HV_MMA(1, 2, V0); SCHEDB();
    HV_MMA(1, 3, V1); SCHEDB();
    __builtin_amdgcn_s_setprio(0);
}
__device__ __forceinline__ void attn_phase(LAS unsigned char* lds, const bf16_t* __restrict__ Q, const unsigned char* __restrict__ KIMG, bf16_t* __restrict__ OL, int bid, int G, int tid, int lane, int wave) {
    const int r32 = lane & 31, hi = lane >> 5;
    const unsigned ldsbase = (unsigned)(uintptr_t)lds;
    const unsigned th = lane >> 5, tblk = (lane >> 4) & 1, tq = (lane & 15) >> 2, tp = lane & 3;
    const unsigned kbase = 2048u * (r32 >> 3) + 64u * (r32 & 7) + 16u * (hi ^ ((r32 >> 2) & 3)), rbase = 128u * r32 + 16u * (hi ^ ((r32 >> 1) & 7));
    const unsigned vbase = 64u * (4 * th + tq) + 16u * ((2 * tblk + (tp >> 1)) ^ th) + 8u * (tp & 1);
#define ATT_WAITV(n) asm volatile("s_waitcnt vmcnt(" #n ")" ::: "memory")
#define ATT_BAR() do { asm volatile("" ::: "memory"); __builtin_amdgcn_s_barrier(); asm volatile("" ::: "memory"); } while (0)
    for (int j = 0;; ++j) {
        const int u = j * G + ((j & 1) ? (G - 1 - bid) : bid);
        if (u >= 2048) break;
        const int i = 511 - (u >> 2), b = (u >> 1) & 1, hg = u & 1;
        const int head = hg * 8 + wave, r0 = i * 32, NT = (r0 + 31) / 64 + 1;
        const bf16_t* qp = Q + ((size_t)(b * S + r0 + r32)) * 3072 + head * 192 + hi * 8;
        bf16x8 qf[12];
#pragma unroll
        for (int s = 0; s < 12; ++s) qf[s] = *(const bf16x8*)(qp + 16 * s);
        f32x16 o[4];
#pragma unroll
        for (int c = 0; c < 4; ++c)
#pragma unroll
            for (int r = 0; r < 16; ++r) o[c][r] = 0.f;
        float mref = 0.f, lsum = 0.f;
        f32x16 negm;
#pragma unroll
        for (int r = 0; r < 16; ++r) negm[r] = 0.f;
        unsigned kcur = kbase, rcur = rbase, vcur = vbase;
        const unsigned char* kt = KIMG + (size_t)(b * 256) * 24576;
        const int qpos = r0 + r32;
#define ATT_STAGE(tile, bufi) do { unsigned l16_ = (unsigned)__builtin_amdgcn_mbcnt_hi(~0u, __builtin_amdgcn_mbcnt_lo(~0u, 0u)) * 16u; asm volatile("" : "+v"(l16_));   \
        _Pragma("unroll") for (int c_ = 0; c_ < 3; ++c_) { const int ch_ = wave + 8 * c_; \
            glds16(kt + (size_t)(tile) * 24576 + ch_ * 1024 + l16_, (unsigned)__builtin_amdgcn_readfirstlane((int)(ldsbase + (bufi) * 24576 + ch_ * 1024))); } } while (0)
        ATT_STAGE(0, 0);
        if (NT > 1) ATT_STAGE(1, 1);
        ATT_WAITV(0);
        ATT_BAR();
#define ATT_ADV(dd) do { kcur += (dd); rcur += (dd); vcur += (dd); } while (0)
#define ATT_TILE(FIRST, LAST, KB0) do { const unsigned ka[2] = {kcur, kcur ^ 32u}, kr[4] = {rcur, rcur ^ 32u, rcur ^ 64u, rcur ^ 96u}, va[2] = {vcur, vcur ^ 32u}; \
            attn_tile2(lds, qf, negm, o, mref, lsum, ka, kr, va, (FIRST), (LAST), r0, (KB0)); } while (0)
        for (int t = 0; t < NT; t += 2) {
            const int nslot = (t & 2) ? 0 : 2;
            if (t + 2 < NT) ATT_STAGE(t + 2, nslot);
            if (t + 3 < NT) ATT_STAGE(t + 3, nslot + 1);
            ATT_TILE(t == 0, t == NT - 1, t * 64);
            ATT_ADV(24576);
            if (t + 1 < NT) ATT_TILE(false, t + 1 == NT - 1, (t + 1) * 64);
            ATT_WAITV(0);
            ATT_BAR();
            if (t & 2) ATT_ADV(-73728); else ATT_ADV(24576);
        }
        const float inv = 1.0f / (lsum + __shfl_xor(lsum, 32));
        LAS unsigned char* stg = lds + 49152 + wave * 8704;
        int ln = (int)__builtin_amdgcn_mbcnt_hi(~0u, __builtin_amdgcn_mbcnt_lo(~0u, 0u)); asm volatile("" : "+v"(ln));
        const int r32e = ln & 31, hie = ln >> 5;
#pragma unroll
        for (int c = 0; c < 4; ++c)
#pragma unroll
            for (int g4 = 0; g4 < 4; ++g4) {
                u32x2 w; w.x = pk2(o[c][4 * g4] * inv, o[c][4 * g4 + 1] * inv); w.y = pk2(o[c][4 * g4 + 2] * inv, o[c][4 * g4 + 3] * inv);
                *(LAS u32x2*)(stg + r32e * 272 + (32 * c + 8 * g4 + 4 * hie) * 2) = w;
            }
        asm volatile("s_waitcnt lgkmcnt(0)" ::: "memory");
        bf16_t* orow = OL + ((size_t)(b * S + r0)) * 2048 + head * 128;
#pragma unroll
        for (int k = 0; k < 8; ++k) {
            const int row = 4 * k + (ln >> 4), ch = ln & 15;
            const u32x4 v = *(const LAS u32x4*)(stg + row * 272 + ch * 16);
            *(u32x4*)(orow + (size_t)row * 2048 + ch * 8) = v;
        }
    }
}

struct Args { const float* in[22]; float* out; unsigned char* ws; };

__device__ __forceinline__ void prologue_phase(const __attribute__((address_space(4))) Args* a, LAS unsigned char* lds, int gw, int NGW, int lane, int wave, int tid, int bid, int G) {
    unsigned char* ws = a->ws;
    LAS float* scr = (LAS float*)(lds + wave * 8448);
    constexpr int IT_G = 8 * 16 * 88, IT_D = 8 * 44 * 32, IT_P = 8 * 4 * 8, IT_KV = 16 * 6, IT_DQ = 2 * 16 * 8, IT_UQR = 2 * 4 * 32;
    constexpr int NITEMS = 2 * IT_G + IT_D + IT_P + IT_KV + IT_DQ + IT_UQR;
    for (int it0 = gw; it0 < NITEMS; it0 += NGW) {
        int it = it0;
        if (it < 2 * IT_G) {
            const int up = it >= IT_G; if (up) it -= IT_G;
            const int f = it / 1408, rem = it % 1408, kb = rem / 88, nb = rem % 88, n0 = nb * 32;
            const float* src = ((f & 1) ? (up ? a->in[8] : a->in[7]) : (up ? a->in[3] : a->in[2])) + (size_t)(f >> 1) * D * FF;
            transpose_item(src, FF, (bf16_t*)(ws + WS_WGU + (size_t)f * SZ_WGU), D, scr, kb * 64, n0, (n0 >> 7) * 256 + (n0 & 127) + (up ? 128 : 0), lane);
            continue;
        }
        it -= 2 * IT_G;
        if (it < IT_D) {
            const int f = it / 1408, rem = it % 1408, kb = rem / 32, nb = rem % 32;
            const float* src = ((f & 1) ? a->in[9] : a->in[4]) + (size_t)(f >> 1) * FF * D;
            transpose_item(src, D, (bf16_t*)(ws + WS_WD + (size_t)f * SZ_WD), FF, scr, kb * 64, nb * 32, nb * 32, lane);
            continue;
        }
        it -= IT_D;
        if (it < IT_P) {
            const int lg = it / 32, rem = it % 32, kb = rem / 8, nb = rem % 8;
            transpose_item(a->in[10] + (size_t)lg * 65536, 256, (bf16_t*)(ws + WS_WP + (size_t)(lg >> 2) * SZ_WP), 256, scr, kb * 64, nb * 32, (lg & 3) * 256 + nb * 32, lane);
            continue;
        }
        it -= IT_P;
        if (it < IT_KV) {
            const int kb = it / 6, nb = it % 6;
            transpose_item(a->in[13], 192, (bf16_t*)(ws + WS_WDKV), D, scr, kb * 64, nb * 32, nb * 32, lane);
            continue;
        }
        it -= IT_KV;
        if (it < IT_DQ) {
            const int jj = it / 128, rem = it % 128, kb = rem / 8, nb = rem % 8;
            transpose_item(a->in[18] + (size_t)jj * D * 256, 256, (bf16_t*)(ws + WS_WDQ + (size_t)jj * 524288), D, scr, kb * 64, nb * 32, nb * 32, lane);
            continue;
        }
        it -= IT_DQ;
        {
            const int jj = it / 128, rem = it % 128, kb = rem / 32, nb = rem % 32, head = nb >> 1, bj = nb & 1;
            transpose_item(a->in[19] + (size_t)jj * 256 * 3072, 3072, (bf16_t*)(ws + WS_WUQ + (size_t)jj * SZ_WUQ), 256, scr, kb * 64, head * 192 + 128 + 32 * bj,
                           2048 + (head >> 2) * 256 + bj * 128 + (head & 3) * 32, lane);
        }
    }
    { u32x4* z = (u32x4*)(ws + WS_WDKV + (size_t)192 * D * 2); const u32x4 zz = {0u, 0u, 0u, 0u};
      for (int i = bid * NTHREADS + tid; i < 64 * D * 2 / 16; i += G * NTHREADS) z[i] = zz; }
    for (int it = gw; it < 1024; it += NGW) {
        const int jj = it >> 9, h = (it >> 5) & 15, rb = (it >> 2) & 7, lb = it & 3, r32 = lane & 31, hi = lane >> 5;
        const float* qa = a->in[19] + (size_t)jj * 256 * 3072 + ((size_t)(rb * 32 + r32) * 16 + h) * 192 + 8 * hi;
        const float* kb = a->in[15] + ((size_t)(lb * 32 + r32) * 16 + h) * 128 + 8 * hi;
        f32x4 av[8][2], bv[8][2];
#pragma unroll
        for (int s = 0; s < 8; ++s) { av[s][0] = *(const f32x4*)(qa + 16 * s); av[s][1] = *(const f32x4*)(qa + 16 * s + 4); bv[s][0] = *(const f32x4*)(kb + 16 * s); bv[s][1] = *(const f32x4*)(kb + 16 * s + 4); }
        f32x16 acc;
#pragma unroll
        for (int r = 0; r < 16; ++r) acc[r] = 0.f;
#pragma unroll
        for (int s = 0; s < 8; ++s) {
            u32x4 pa, pb;
            pa.x = pk2(av[s][0].x, av[s][0].y); pa.y = pk2(av[s][0].z, av[s][0].w); pa.z = pk2(av[s][1].x, av[s][1].y); pa.w = pk2(av[s][1].z, av[s][1].w);
            pb.x = pk2(bv[s][0].x, bv[s][0].y); pb.y = pk2(bv[s][0].z, bv[s][0].w); pb.z = pk2(bv[s][1].x, bv[s][1].y); pb.w = pk2(bv[s][1].z, bv[s][1].w);
            acc = __builtin_amdgcn_mfma_f32_32x32x16_bf16(__builtin_bit_cast(bf16x8, pa), __builtin_bit_cast(bf16x8, pb), acc, 0, 0, 0);
        }
        bf16_t* dst = (bf16_t*)(ws + WS_WUQ + (size_t)jj * SZ_WUQ) + (size_t)(h * 128 + lb * 32 + r32) * 256 + rb * 32 + 4 * hi;
#pragma unroll
        for (int g4 = 0; g4 < 4; ++g4) { u32x2 w; w.x = pk2(acc[4 * g4], acc[4 * g4 + 1]); w.y = pk2(acc[4 * g4 + 2], acc[4 * g4 + 3]); *(u32x2*)(dst + 8 * g4) = w; }
    }
    for (int it = gw; it < 4096; it += NGW) {
        const int jj = it >> 11, h = (it >> 7) & 15, lb = (it >> 5) & 3, nb = it & 31, r32 = lane & 31, hi = lane >> 5;
        const float* va = a->in[16] + ((size_t)(lb * 32 + r32) * 16 + h) * 128 + 8 * hi;
        const float* ob = a->in[20] + (size_t)jj * 2048 * 1024 + (size_t)(h * 128 + 8 * hi) * 1024 + nb * 32 + r32;
        f32x16 acc;
#pragma unroll
        for (int r = 0; r < 16; ++r) acc[r] = 0.f;
#pragma unroll 2
        for (int s = 0; s < 8; ++s) {
            const f32x4 a0 = *(const f32x4*)(va + 16 * s), a1 = *(const f32x4*)(va + 16 * s + 4);
            float bq[8];
#pragma unroll
            for (int q = 0; q < 8; ++q) bq[q] = ob[(size_t)(16 * s + q) * 1024];
            u32x4 pa, pb;
            pa.x = pk2(a0.x, a0.y); pa.y = pk2(a0.z, a0.w); pa.z = pk2(a1.x, a1.y); pa.w = pk2(a1.z, a1.w);
            pb.x = pk2(bq[0], bq[1]); pb.y = pk2(bq[2], bq[3]); pb.z = pk2(bq[4], bq[5]); pb.w = pk2(bq[6], bq[7]);
            acc = __builtin_amdgcn_mfma_f32_32x32x16_bf16(__builtin_bit_cast(bf16x8, pa), __builtin_bit_cast(bf16x8, pb), acc, 0, 0, 0);
        }
        bf16_t* dst = (bf16_t*)(ws + WS_WOV + (size_t)jj * SZ_WOV) + (size_t)(nb * 32 + r32) * 2048 + h * 128 + lb * 32 + 4 * hi;
#pragma unroll
        for (int g4 = 0; g4 < 4; ++g4) { u32x2 w; w.x = pk2(acc[4 * g4], acc[4 * g4 + 1]); w.y = pk2(acc[4 * g4 + 2], acc[4 * g4 + 3]); *(u32x2*)(dst + 8 * g4) = w; }
    }
    { float* COS = (float*)(ws + WS_COS); float* SIN = (float*)(ws + WS_SIN);
      for (int idx = bid * NTHREADS + tid; idx < S * 32; idx += G * NTHREADS) {
          const int pos = idx >> 5, i = idx & 31;
          const float invf = exp2f(-(float)i * (13.287712379549449f / 32.0f));
          const float ang = (float)pos * invf;
          double xr = (double)ang * 0.15915494309189535; xr -= __builtin_rint(xr);
          const float rev = (float)xr;
          COS[idx] = __builtin_amdgcn_cosf(rev); SIN[idx] = __builtin_amdgcn_sinf(rev);
      } }
    norm_phase(a->in[0], a->in[1], (bf16_t*)(ws + WS_R1), gw, NGW, lane);
}

constexpr size_t WS_BAR = WS_END;
__device__ __forceinline__ unsigned xcc_id() { return (unsigned)__builtin_amdgcn_s_getreg((3 << 11) | 20) & 0xFu; }
__device__ __forceinline__ void grid_bar(unsigned* bar, unsigned k, unsigned x, unsigned nloc, unsigned nx) {
    asm volatile("s_waitcnt vmcnt(0) lgkmcnt(0)" ::: "memory");
    __syncthreads();
    if (threadIdx.x == 0) {
        const unsigned old = __hip_atomic_fetch_add(bar + 16 + x, 1u, __ATOMIC_RELAXED, __HIP_MEMORY_SCOPE_AGENT);
        if (old + 1u == k * nloc) {
            __builtin_amdgcn_fence(__ATOMIC_RELEASE, "agent");
            asm volatile("s_waitcnt vmcnt(0)" ::: "memory");
            __hip_atomic_fetch_add(bar, 1u, __ATOMIC_RELAXED, __HIP_MEMORY_SCOPE_AGENT);
        }
        while (__hip_atomic_load(bar, __ATOMIC_RELAXED, __HIP_MEMORY_SCOPE_AGENT) < k * nx) __builtin_amdgcn_s_sleep(1);
        __builtin_amdgcn_fence(__ATOMIC_ACQUIRE, "agent");
        asm volatile("s_waitcnt vmcnt(0)" ::: "memory");
    }
    __syncthreads();
}
#define GSYNC() do { ++bar_k; grid_bar((unsigned*)(((ArgsP)__builtin_amdgcn_kernarg_segment_ptr())->ws + WS_BAR), (unsigned)bar_k, bar_x, bar_nloc, bar_nx); } while (0)
typedef const __attribute__((address_space(4))) Args* ArgsP;
#define PHASE_IDS() int tid = threadIdx.x; asm volatile("" : "+v"(tid)); const int lane = tid & 63, wave = __builtin_amdgcn_readfirstlane(tid >> 6); \
    int bid_l = blockIdx.x, G_l = gridDim.x; asm volatile("" : "+s"(bid_l), "+s"(G_l)); const int bid = bid_l, G = G_l, gw = bid * NWAVES + wave, NGW = G * NWAVES; \
    ArgsP ap = (ArgsP)__builtin_amdgcn_kernarg_segment_ptr(); asm volatile("" : "+s"(ap)); unsigned char* ws = ap->ws; float* Hout = ap->out; bf16_t* Hb = (bf16_t*)((unsigned char*)ap->out + 67108864);     \
    (void)lane; (void)gw; (void)NGW; (void)ws; (void)bid; (void)G; (void)Hout; (void)Hb;
__global__ void __launch_bounds__(NTHREADS, 2) yoco_fwd(Args a) {
    extern __shared__ __attribute__((aligned(16))) unsigned char lds_raw[];
    LAS unsigned char* lds = (LAS unsigned char*)lds_raw;
    const unsigned bar_x = xcc_id();
    if (threadIdx.x == 0) __hip_atomic_fetch_add((unsigned*)(a.ws + WS_BAR) + 32 + bar_x, 1u, __ATOMIC_RELAXED, __HIP_MEMORY_SCOPE_AGENT);
    { PHASE_IDS(); prologue_phase(ap, lds, gw, NGW, lane, wave, tid, bid, G); }
    cg::this_grid().sync();
    int bar_k = 0;
    unsigned bar_nloc = 1, bar_nx = 0;
    { const unsigned* cen = (const unsigned*)(a.ws + WS_BAR) + 32;
#pragma unroll
      for (unsigned j = 0; j < 16; ++j) { const unsigned c = __hip_atomic_load(cen + j, __ATOMIC_RELAXED, __HIP_MEMORY_SCOPE_AGENT); bar_nx += (c > 0u) ? 1u : 0u; if (j == bar_x) bar_nloc = c; } }
    for (int f = 0; f < 8; ++f) {
        const int l = f >> 1;
        { PHASE_IDS(); pg8::Gemm g{(const bf16_t*)(ws + WS_R1), (const bf16_t*)(ws + WS_WGU + (size_t)f * SZ_WGU), T, 2 * FF, D}; pg8::StaticOrder So; So.init(T, 2 * FF, G, bid);
          EpiSwiGLU E{(bf16_t*)(ws + WS_R3)}; pg8::gemm_phase<EpiSwiGLU, pg8::StaticOrder, true, true>(lds, g, So, E); }
        GSYNC();
        { PHASE_IDS(); pg8::Gemm g{(const bf16_t*)(ws + WS_R3), (const bf16_t*)(ws + WS_WD + (size_t)f * SZ_WD), T, D, FF}; pg8::StaticOrder So; So.init(T, D, G, bid);
          EpiResidB<true, 0x7fffffff> E{(f == 0 ? ap->in[0] : (const float*)nullptr), Hb, Hb, nullptr}; pg8::gemm_phase<EpiResidB<true, 0x7fffffff>, pg8::StaticOrder, true, true>(lds, g, So, E); }
        GSYNC();
        if ((f & 1) == 0) {
            if (l < 2) {
                { PHASE_IDS(); pool_y_phase(Hb, ap->in[5] + l * D, (bf16_t*)(ws + WS_R3), (LAS float*)lds, bid, G, tid, lane, wave); }
                GSYNC();
                { PHASE_IDS(); pg8::Gemm g{(const bf16_t*)(ws + WS_R3), (const bf16_t*)(ws + WS_WP + (size_t)l * SZ_WP), 4 * T, D, 256}; PoolOrder So{G, bid};
                  EpiResidB<false, 127> E{nullptr, Hb, Hb, ap->in[11] + l * D}; pg8::gemm_phase<EpiResidB<false, 127>, PoolOrder, true, true>(lds, g, So, E); }
                GSYNC();
            } else {
                const int jj = l - 2;
                { PHASE_IDS(); norm_phase16(Hb, ap->in[5] + l * D, (bf16_t*)(ws + WS_R1), gw, NGW, lane); }
                GSYNC();
                { PHASE_IDS(); pg8::Gemm g{(const bf16_t*)(ws + WS_R1), (const bf16_t*)(ws + WS_WDQ + (size_t)jj * 524288), T, 256, D}; pg8::StaticOrder So; So.init(T, 256, G, bid);
                  EpiF32 E{(float*)(ws + WS_RAW)}; pg8::gemm_phase<EpiF32, pg8::StaticOrder, true, true>(lds, g, So, E); }
                GSYNC();
                { PHASE_IDS(); cq_norm_phase((const float*)(ws + WS_RAW), ap->in[17] + jj * 256, (bf16_t*)(ws + WS_CQ), gw, NGW, lane); }
                GSYNC();
                { PHASE_IDS(); pg8::Gemm g{(const bf16_t*)(ws + WS_CQ), (const bf16_t*)(ws + WS_WUQ + (size_t)jj * SZ_WUQ), T, 2048, 256}; pg8::StaticOrder So; So.init(T, 2048, G, bid);
                  EpiQN E{(bf16_t*)(ws + WS_R3)}; pg8::gemm_phase<EpiQN, pg8::StaticOrder, true, true>(lds, g, So, E); }
                { PHASE_IDS(); pg8::Gemm g{(const bf16_t*)(ws + WS_CQ), (const bf16_t*)(ws + WS_WUQ + (size_t)jj * SZ_WUQ + (size_t)2048 * 256 * 2), T, 1024, 256}; pg8::StaticOrder So; So.init(T, 1024, G, bid);
                  EpiQR E{(bf16_t*)(ws + WS_R3), (const float*)(ws + WS_COS), (const float*)(ws + WS_SIN)}; pg8::gemm_phase<EpiQR, pg8::StaticOrder, true, true>(lds, g, So, E); }
                GSYNC();
                { PHASE_IDS(); attn_phase(lds, (const bf16_t*)(ws + WS_R3), ws + WS_KIMG, (bf16_t*)(ws + WS_R1), bid, G, tid, lane, wave); }
                GSYNC();
                { PHASE_IDS(); pg8::Gemm g{(const bf16_t*)(ws + WS_R1), (const bf16_t*)(ws + WS_WOV + (size_t)jj * SZ_WOV), T, D, 2048}; pg8::StaticOrder So; So.init(T, D, G, bid);
                  EpiResidB<false, 0x7fffffff> E{nullptr, Hb, Hb, nullptr}; pg8::gemm_phase<EpiResidB<false, 0x7fffffff>, pg8::StaticOrder, true, true>(lds, g, So, E); }
                GSYNC();
            }
            { PHASE_IDS(); norm_phase16(Hb, ap->in[6] + l * D, (bf16_t*)(ws + WS_R1), gw, NGW, lane); }
            GSYNC();
        } else {
            if (l == 1) {
                { PHASE_IDS(); norm_phase16(Hb, ap->in[12], (bf16_t*)(ws + WS_R1), gw, NGW, lane); }
                GSYNC();
                { PHASE_IDS(); pg8::Gemm g{(const bf16_t*)(ws + WS_R1), (const bf16_t*)(ws + WS_WDKV), T, 256, D}; pg8::StaticOrder So; So.init(T, 256, G, bid);
                  EpiF32 E{(float*)(ws + WS_RAW)}; pg8::gemm_phase<EpiF32, pg8::StaticOrder, true, true>(lds, g, So, E); }
                GSYNC();
                { PHASE_IDS(); kv_prep_phase((const float*)(ws + WS_RAW), ap->in[14], (const float*)(ws + WS_COS), (const float*)(ws + WS_SIN), ws + WS_KIMG, gw, NGW, lane); }
            }
            if (l < 3) { { PHASE_IDS(); norm_phase16(Hb, ap->in[1] + (l + 1) * D, (bf16_t*)(ws + WS_R1), gw, NGW, lane); } GSYNC(); }
        }
    }
    { PHASE_IDS();
      u32x4 fa[16], fb[16];
#pragma unroll
      for (int k = 0; k < 16; ++k) { const int m = gw + k * NGW; if (m < T) { fa[k] = *(const u32x4*)(Hb + (size_t)m * D + 8 * lane); fb[k] = *(const u32x4*)(Hb + (size_t)m * D + 512 + 8 * lane); } }
      GSYNC();
      const float* gain = ap->in[21];
      f32x4 g4[4];
      g4[0] = *(const f32x4*)(gain + 8 * lane); g4[1] = *(const f32x4*)(gain + 8 * lane + 4); g4[2] = *(const f32x4*)(gain + 512 + 8 * lane); g4[3] = *(const f32x4*)(gain + 512 + 8 * lane + 4);
#pragma unroll
      for (int k = 0; k < 16; ++k) { const int m = gw + k * NGW; if (m < T) {
          f32x4 v[4]; v[0] = bf_lo4(fa[k].x, fa[k].y); v[1] = bf_lo4(fa[k].z, fa[k].w); v[2] = bf_lo4(fb[k].x, fb[k].y); v[3] = bf_lo4(fb[k].z, fb[k].w);
          float sq = 0.f;
#pragma unroll
          for (int jx = 0; jx < 4; ++jx) sq += dot4(v[jx], v[jx]);
          const float rstd = 1.0f / sqrtf(wave_sum(sq) * (1.0f / D) + RMS_EPS);
          float* orow = Hout + (size_t)m * D;
          *(f32x4*)(orow + 8 * lane) = v[0] * rstd * g4[0]; *(f32x4*)(orow + 8 * lane + 4) = v[1] * rstd * g4[1];
          *(f32x4*)(orow + 512 + 8 * lane) = v[2] * rstd * g4[2]; *(f32x4*)(orow + 512 + 8 * lane + 4) = v[3] * rstd * g4[3]; } }
    }
}

extern "C" void kernel_launch(void* const* d_in, const int* in_sizes, int n_in, void* d_out, int out_size, void* d_ws, size_t ws_size, hipStream_t stream) {
    static int grid_blocks = 0;
    if (grid_blocks == 0) {
        if (n_in != 22 || out_size != T * D || ws_size < WS_END + 256) { fprintf(stderr, "kernel_launch: unexpected shapes (n_in %d out %d ws %zu need %zu)\n", n_in, out_size, ws_size, (size_t)WS_END); grid_blocks = -1; return; }
        int dev = 0, cus = 0, per_cu = 0;
        hipGetDevice(&dev);
        hipDeviceGetAttribute(&cus, hipDeviceAttributeMultiprocessorCount, dev);
        if (hipFuncSetAttribute((const void*)yoco_fwd, hipFuncAttributeMaxDynamicSharedMemorySize, LDS_BYTES) != hipSuccess) { fprintf(stderr, "kernel_launch: hipFuncSetAttribute failed\n"); }
        hipOccupancyMaxActiveBlocksPerMultiprocessor(&per_cu, (const void*)yoco_fwd, NTHREADS, LDS_BYTES);
        if (per_cu < 1) { fprintf(stderr, "kernel_launch: occupancy query says %d blocks per CU\n", per_cu); per_cu = 1; }
        grid_blocks = cus;
        if ((long)cus * NWAVES * 16 < T) { fprintf(stderr, "kernel_launch: this build needs >= %d workgroups (final norm holds 16 rows per wave); device has %d CUs\n", T / (NWAVES * 16), cus); grid_blocks = -1; return; }
        (void)hipGetLastError();
    }
    if (grid_blocks < 0) return;
    if (hipMemsetAsync((unsigned char*)d_ws + WS_BAR, 0, 256, stream) != hipSuccess) { fprintf(stderr, "kernel_launch: memset of the barrier word failed\n"); return; }
    Args a{};
    for (int i = 0; i < 22; ++i) a.in[i] = (const float*)d_in[i];
    a.out = (float*)d_out; a.ws = (unsigned char*)d_ws;
    void* args[] = {&a};
    hipError_t e = hipLaunchCooperativeKernel((const void*)yoco_fwd, dim3(grid_blocks), dim3(NTHREADS), args, LDS_BYTES, stream);
    if (e != hipSuccess) fprintf(stderr, "cooperative launch failed: %s (grid %d)\n", hipGetErrorString(e), grid_blocks);
}
```

```cpp
#include <hip/hip_runtime.h>
#include <hip/hip_cooperative_groups.h>
#include <cstdio>
#include <cstdint>
namespace cg = cooperative_groups;
namespace pg8 {
#define PG8_LAS __attribute__((address_space(3)))
typedef unsigned short bf16_t;
typedef short bf16x8 __attribute__((ext_vector_type(8)));
typedef float f32x4 __attribute__((ext_vector_type(4)));
typedef unsigned u32x4 __attribute__((ext_vector_type(4)));
constexpr int BM = 256, BK = 64, HALF = 128, HTB = HALF * BK * 2  , STAGE_BYTES = 8 * HTB, NXCD = 8, WGM = 8;

__host__ __device__ __forceinline__ int lds_byte(int r, int c) { const int st = (r >> 4) * 2 + (c >> 5), rr = r & 15, cc = c & 31, ob = rr * 64 + cc * 2; return st * 1024 + (ob ^ (((ob >> 9) & 1) << 5)); }
__host__ __device__ __forceinline__ void stage_rc(int b, int& R, int& C) { const int st = b / 1024, sb = b % 1024, swz = sb ^ (((sb >> 9) & 1) << 5); R = (st >> 1) * 16 + swz / 64; C = (st & 1) * 32 + (swz % 64) / 2; }
__host__ __device__ __forceinline__ int perm32(int rho) { const int n = rho >> 4, i = rho & 15; return 8 * (i >> 2) + 4 * n + (i & 3); }

struct Unit { int pm, pn; };
struct Gemm { const bf16_t* A; const bf16_t* Bt; int M, N, K; };

struct StaticOrder {
    int nM, nN, nwg, G, c;
    __host__ __device__ void init(int M, int N, int G_, int c_) { nM = M / BM; nN = N / BM; nwg = nM * nN; G = G_; c = c_; }
    __host__ __device__ bool next(int i, Unit& u) const {
        const long L = (long)i * G + c; if (L >= nwg) return false;
        int wgid = (int)L; { const int q = nwg / NXCD, r = nwg % NXCD, xcd = wgid % NXCD, off = wgid / NXCD; wgid = (xcd < r ? xcd * (q + 1) : r * (q + 1) + (xcd - r) * q) + off; }
        const int nig = WGM * nN, gid = wgid / nig, fm = gid * WGM, gsz = (nM - fm) < WGM ? (nM - fm) : WGM;
        u.pm = fm + ((wgid % nig) % gsz); u.pn = (wgid % nig) / gsz; return true;
    }
    __device__ __forceinline__ void a_ready(const Unit&) const {}
    __device__ __forceinline__ void done(const Unit&) const {}
};

template <class Epi, class Sched, bool ALIGN_EPI = false, bool SP2 = false>
__device__ __forceinline__ void gemm_phase(PG8_LAS unsigned char* lds, const Gemm g, const Sched& S, const Epi& E) {
    int tid_l = threadIdx.x; asm volatile("" : "+v"(tid_l));
    const int tid = tid_l, wid = __builtin_amdgcn_readfirstlane(tid >> 6), lane = tid & 63, wr = wid >> 2, wc = wid & 3, fr = lane & 15, fq = lane >> 4;
    const int K = g.K, nt = K / BK;
    unsigned voffA[2], voffB[2];
#pragma unroll
    for (int i = 0; i < 2; ++i) { int R, C; stage_rc(tid * 16 + i * 8192, R, C); const int Rb = Epi::PERM ? ((R & ~31) + perm32(R & 31)) : R;
        voffA[i] = (unsigned)(R * K + C) * 2u; voffB[i] = (unsigned)(Rb * K + C) * 2u; }
    const size_t kstep = (size_t)(BK * 2);
    const size_t hstep = (size_t)HALF * K * 2;
    const size_t tstep = 2 * hstep;
    const unsigned ldsw = (unsigned)wid * 1024u;
    const int aoff = lds_byte(wr * 64 + fr, fq * 8), boff = lds_byte(wc * 32 + fr, fq * 8);
#define PG8_SA(b, h) (((b) * 2 + (h)) * HTB)
#define PG8_SB(b, h) ((4 + (b) * 2 + (h)) * HTB)
#define PG8_STAGE(bufoff, gbase, voff) do { _Pragma("unroll") for (int _i = 0; _i < 2; ++_i) \
        __builtin_amdgcn_global_load_lds((const unsigned*)((const char*)(gbase) + (voff)[_i]), (PG8_LAS unsigned*)(lds + (bufoff) + ldsw + _i * 8192), 16, 0, 0); } while (0)
#define PG8_LDA(dst, b, h) do { _Pragma("unroll") for (int m = 0; m < 4; ++m) _Pragma("unroll") for (int k = 0; k < 2; ++k) dst[m][k] = *(const PG8_LAS bf16x8*)(lds + PG8_SA(b, h) + aoff + m * 2048 + k * 1024); } while (0)
#define PG8_LDB(dst, b, h) do { _Pragma("unroll") for (int n = 0; n < 2; ++n) _Pragma("unroll") for (int k = 0; k < 2; ++k) dst[n][k] = *(const PG8_LAS bf16x8*)(lds + PG8_SB(b, h) + boff + n * 2048 + k * 1024); } while (0)
#define PG8_MMA(ai, bj, At, Bt) do { __builtin_amdgcn_s_setprio(1); _Pragma("unroll") for (int m = 0; m < 4; ++m) _Pragma("unroll") for (int n = 0; n < 2; ++n) _Pragma("unroll") for (int k = 0; k < 2; ++k) \
        acc[ai][bj][m][n] = __builtin_amdgcn_mfma_f32_16x16x32_bf16(Bt[n][k], At[m][k], acc[ai][bj][m][n], 0, 0, 0); __builtin_amdgcn_s_setprio(0); } while (0)
#define PG8_WAIT_V(n) asm volatile("s_waitcnt vmcnt(" #n ")" ::: "memory")
#define PG8_WAIT_L(n) asm volatile("s_waitcnt lgkmcnt(" #n ")" ::: "memory")
#define PG8_BAR __builtin_amdgcn_s_barrier()
#define PG8_SCHED __builtin_amdgcn_sched_barrier(0)
    Unit cur, nxt; int ui = 0;
    if (!S.next(0, cur)) return;
    f32x4 acc[2][2][4][2];
#pragma unroll
    for (int a = 0; a < 2; ++a)
#pragma unroll
        for (int b = 0; b < 2; ++b)
#pragma unroll
            for (int m = 0; m < 4; ++m)
#pragma unroll
                for (int n = 0; n < 2; ++n) acc[a][b][m][n] = (f32x4){0.f, 0.f, 0.f, 0.f};
    bf16x8 At[4][2], B0[2][2], B1[2][2];
    const char* cA = (const char*)g.A + (size_t)cur.pm * tstep; const char* cB = (const char*)g.Bt + (size_t)cur.pn * tstep;
    S.a_ready(cur);
    if constexpr (SP2) {
        PG8_STAGE(PG8_SB(0, 0), cB, voffB); PG8_STAGE(PG8_SB(0, 1), cB + hstep, voffB); PG8_STAGE(PG8_SA(0, 0), cA, voffA); PG8_STAGE(PG8_SA(0, 1), cA + hstep, voffA);
        if (wr == 1) PG8_BAR;
        PG8_WAIT_V(2); PG8_BAR;
        PG8_STAGE(PG8_SB(1, 0), cB + kstep, voffB); PG8_STAGE(PG8_SA(1, 0), cA + kstep, voffA); PG8_STAGE(PG8_SB(1, 1), cB + hstep + kstep, voffB);
        PG8_WAIT_V(6); PG8_BAR;
    } else {
        PG8_STAGE(PG8_SB(0, 0), cB, voffB); PG8_STAGE(PG8_SA(0, 0), cA, voffA); PG8_STAGE(PG8_SB(0, 1), cB + hstep, voffB); PG8_STAGE(PG8_SA(0, 1), cA + hstep, voffA);
        if (wr == 1) PG8_BAR;
        PG8_WAIT_V(4); PG8_BAR;
        PG8_STAGE(PG8_SB(1, 0), cB + kstep, voffB); PG8_STAGE(PG8_SA(1, 0), cA + kstep, voffA); PG8_STAGE(PG8_SB(1, 1), cB + hstep + kstep, voffB);
        PG8_WAIT_V(6); PG8_BAR;
    }
    for (;;) {
        const bool has_next = S.next(ui + 1, nxt);
        const char* nA = has_next ? (const char*)g.A + (size_t)nxt.pm * tstep : cA; const char* nB = has_next ? (const char*)g.Bt + (size_t)nxt.pn * tstep : cB;
#pragma unroll 1
        for (int t = 0; t < nt; t += 2) {
            const bool last = (t == nt - 2);
            const char* a1 = cA + (size_t)(t + 1) * kstep;
            const char* a2 = last ? nA : cA + (size_t)(t + 2) * kstep; const char* b2 = last ? nB : cB + (size_t)(t + 2) * kstep;
            const char* a3 = a2 + kstep; const char* b3 = b2 + kstep;
            if (last && has_next) S.a_ready(nxt);
            if constexpr (SP2) {
            PG8_LDB(B0, 0, 0); PG8_LDB(B1, 0, 1); PG8_SCHED; PG8_LDA(At, 0, 0); PG8_STAGE(PG8_SA(1, 1), a1 + hstep, voffA);
            PG8_WAIT_V(8); PG8_WAIT_L(0); PG8_BAR; PG8_MMA(0, 0, At, B0); PG8_MMA(0, 1, At, B1); PG8_BAR; PG8_SCHED;
            PG8_LDA(At, 0, 1); PG8_STAGE(PG8_SB(0, 0), b2, voffB); PG8_STAGE(PG8_SB(0, 1), b2 + hstep, voffB); PG8_STAGE(PG8_SA(0, 0), a2, voffA);
            PG8_WAIT_V(8); PG8_WAIT_L(0); PG8_BAR; PG8_MMA(1, 0, At, B0); PG8_MMA(1, 1, At, B1); PG8_BAR; PG8_SCHED;
            PG8_LDB(B0, 1, 0); PG8_LDB(B1, 1, 1); PG8_SCHED; PG8_LDA(At, 1, 0); PG8_STAGE(PG8_SA(0, 1), a2 + hstep, voffA);
            PG8_WAIT_V(8); PG8_WAIT_L(0); PG8_BAR; PG8_MMA(0, 0, At, B0); PG8_MMA(0, 1, At, B1); PG8_BAR; PG8_SCHED;
            PG8_LDA(At, 1, 1); PG8_STAGE(PG8_SB(1, 0), b3, voffB); PG8_STAGE(PG8_SB(1, 1), b3 + hstep, voffB); PG8_STAGE(PG8_SA(1, 0), a3, voffA);
            PG8_WAIT_V(8); PG8_WAIT_L(0); PG8_BAR; PG8_MMA(1, 0, At, B0); PG8_MMA(1, 1, At, B1); PG8_BAR; PG8_SCHED;
            } else {
            PG8_LDB(B0, 0, 0); PG8_SCHED; PG8_LDA(At, 0, 0); PG8_STAGE(PG8_SA(1, 1), a1 + hstep, voffA);
            PG8_WAIT_L(8); PG8_BAR; PG8_WAIT_L(0); PG8_MMA(0, 0, At, B0); PG8_BAR; PG8_SCHED;
            PG8_LDB(B1, 0, 1); PG8_STAGE(PG8_SB(0, 0), b2, voffB);
            PG8_BAR; PG8_WAIT_L(0); PG8_MMA(0, 1, At, B1); PG8_BAR;
            PG8_LDA(At, 0, 1); PG8_STAGE(PG8_SA(0, 0), a2, voffA);
            PG8_BAR; PG8_WAIT_L(0); PG8_MMA(1, 0, At, B0); PG8_BAR; PG8_SCHED;
            PG8_STAGE(PG8_SB(0, 1), b2 + hstep, voffB);
            PG8_WAIT_V(6); PG8_BAR; PG8_MMA(1, 1, At, B1); PG8_BAR;
            PG8_LDB(B0, 1, 0); PG8_SCHED; PG8_LDA(At, 1, 0); PG8_STAGE(PG8_SA(0, 1), a2 + hstep, voffA);
            PG8_WAIT_L(8); PG8_BAR; PG8_WAIT_L(0); PG8_MMA(0, 0, At, B0); PG8_BAR; PG8_SCHED;
            PG8_LDB(B1, 1, 1); PG8_STAGE(PG8_SB(1, 0), b3, voffB);
            PG8_BAR; PG8_WAIT_L(0); PG8_MMA(0, 1, At, B1); PG8_BAR;
            PG8_LDA(At, 1, 1); PG8_STAGE(PG8_SA(1, 0), a3, voffA);
            PG8_BAR; PG8_WAIT_L(0); PG8_MMA(1, 0, At, B0); PG8_BAR; PG8_SCHED;
            PG8_STAGE(PG8_SB(1, 1), b3 + hstep, voffB);
            PG8_WAIT_V(6); PG8_BAR; PG8_MMA(1, 1, At, B1); PG8_BAR;
            }
        }
        if constexpr (ALIGN_EPI) { if (wr == 0) PG8_BAR; }
        if constexpr (!Epi::AFTER_DRAIN) { E(acc, cur, wr, wc, fr, fq); S.done(cur); }
        if (!has_next) break;
#pragma unroll
        for (int a = 0; a < 2; ++a)
#pragma unroll
            for (int b = 0; b < 2; ++b)
#pragma unroll
                for (int m = 0; m < 4; ++m)
#pragma unroll
                    for (int n = 0; n < 2; ++n) acc[a][b][m][n] = (f32x4){0.f, 0.f, 0.f, 0.f};
        cur = nxt; cA = nA; cB = nB; ++ui;
        if constexpr (ALIGN_EPI) { if (wr == 1) PG8_BAR; }
    }
    PG8_WAIT_V(0);
    if constexpr (!ALIGN_EPI) { if (wr == 0) PG8_BAR; }
    PG8_BAR;
    if constexpr (Epi::AFTER_DRAIN) { E.fused(acc, cur, wr, wc, fr, fq, lds, wid, lane); S.done(cur); }
#undef PG8_SA
#undef PG8_SB
#undef PG8_STAGE
#undef PG8_LDA
#undef PG8_LDB
#undef PG8_MMA
#undef PG8_WAIT_V
#undef PG8_WAIT_L
#undef PG8_BAR
#undef PG8_SCHED
}
}

#define LAS __attribute__((address_space(3)))
typedef unsigned short bf16_t;
typedef short bf16x8 __attribute__((ext_vector_type(8)));
typedef short s16x4 __attribute__((ext_vector_type(4)));
typedef float f32x4 __attribute__((ext_vector_type(4)));
typedef float f32x16 __attribute__((ext_vector_type(16)));
typedef unsigned u32x4 __attribute__((ext_vector_type(4)));
typedef unsigned u32x2 __attribute__((ext_vector_type(2)));

constexpr int D = 1024, NB = 2, S = 16384, T = NB * S, FF = 2816, NH = 16;
constexpr int NTHREADS = 512, NWAVES = 8;
constexpr int LDS_BYTES = 131072;
constexpr float RMS_EPS = 1e-6f;
constexpr float C2 = 0.07216878364870322f * 1.4426950408889634f;

constexpr size_t WS_R1 = 0;
constexpr size_t WS_R2 = 67108864;
constexpr size_t WS_RAW = WS_R2, WS_CQ = WS_R2 + 33554432;
constexpr size_t WS_R3 = 134217728;
constexpr size_t WS_KIMG = WS_R3 + 201326592;
constexpr size_t WS_COS = WS_KIMG + 12582912;
constexpr size_t WS_SIN = WS_COS + 2097152;
constexpr size_t WS_WGU = WS_SIN + 2097152;
constexpr size_t SZ_WGU = (size_t)5632 * 1024 * 2;
constexpr size_t WS_WD = WS_WGU + 8 * SZ_WGU;
constexpr size_t SZ_WD = (size_t)1024 * 2816 * 2;
constexpr size_t WS_WP = WS_WD + 8 * SZ_WD;
constexpr size_t SZ_WP = (size_t)1024 * 256 * 2;
constexpr size_t WS_WDKV = WS_WP + 2 * SZ_WP;
constexpr size_t WS_WDQ = WS_WDKV + 524288;
constexpr size_t WS_WUQ = WS_WDQ + 2 * 524288;
constexpr size_t SZ_WUQ = (size_t)3072 * 256 * 2;
constexpr size_t WS_WOV = WS_WUQ + 2 * SZ_WUQ;
constexpr size_t SZ_WOV = (size_t)1024 * 2048 * 2;
constexpr size_t WS_END = WS_WOV + 2 * SZ_WOV;

__device__ __forceinline__ unsigned pk2(float lo, float hi) {
    typedef float f2 __attribute__((ext_vector_type(2))); typedef __bf16 b2 __attribute__((ext_vector_type(2)));
    f2 v = {lo, hi}; b2 b = __builtin_convertvector(v, b2); return __builtin_bit_cast(unsigned, b);
}
__device__ __forceinline__ bf16_t bf1(float x) { return (bf16_t)(pk2(x, 0.f) & 0xffffu); }
__device__ __forceinline__ float wave_sum(float v) {
#pragma unroll
    for (int o = 1; o < 64; o <<= 1) v += __shfl_xor(v, o);
    return v;
}
__device__ __forceinline__ float dot4(f32x4 a, f32x4 b) { return (a.x * b.x + a.y * b.y) + (a.z * b.z + a.w * b.w); }

using pg8::Unit;
struct EpiSwiGLU {
    static constexpr bool PERM = true, AFTER_DRAIN = false;
    bf16_t* O;
    __device__ __forceinline__ void operator()(const f32x4 (&acc)[2][2][4][2], const Unit& u, int wr, int wc, int fr, int fq) const {
        const int row0 = u.pm * 256 + wr * 64 + fr, col0 = u.pn * 128 + wc * 32 + 8 * fq;
#pragma unroll
        for (int ai = 0; ai < 2; ++ai)
#pragma unroll
            for (int m = 0; m < 4; ++m) {
                float r[8];
#pragma unroll
                for (int n = 0; n < 2; ++n)
#pragma unroll
                    for (int j = 0; j < 4; ++j) {
                        const float g = acc[ai][0][m][n][j], up = acc[ai][1][m][n][j];
                        const float e = __builtin_amdgcn_exp2f(-1.4426950408889634f * g);
                        r[4 * n + j] = g * __builtin_amdgcn_rcpf(1.0f + e) * up;
                    }
                u32x4 w; w.x = pk2(r[0], r[1]); w.y = pk2(r[2], r[3]); w.z = pk2(r[4], r[5]); w.w = pk2(r[6], r[7]);
                *(u32x4*)(O + (size_t)(row0 + ai * 128 + m * 16) * FF + col0) = w;
            }
    }
};
struct EpiResid {
    static constexpr bool PERM = false, AFTER_DRAIN = false;
    const float* base; float* out; const float* scale; float alpha; int pm_mask;
    __device__ __forceinline__ void operator()(const f32x4 (&acc)[2][2][4][2], const Unit& u, int wr, int wc, int fr, int fq) const {
        const int row0 = (u.pm & pm_mask) * 256 + wr * 64 + fr, col0 = u.pn * 256 + wc * 32 + 4 * fq;
        f32x4 sc[2][2];
#pragma unroll
        for (int bj = 0; bj < 2; ++bj)
#pragma unroll
            for (int n = 0; n < 2; ++n) { sc[bj][n] = (f32x4){alpha, alpha, alpha, alpha}; if (scale) sc[bj][n] = sc[bj][n] * *(const f32x4*)(scale + col0 + bj * 128 + n * 16); }
#pragma unroll
        for (int ai = 0; ai < 2; ++ai)
#pragma unroll
            for (int m = 0; m < 4; ++m) {
                const size_t off = (size_t)(row0 + ai * 128 + m * 16) * D + col0;
#pragma unroll
                for (int bj = 0; bj < 2; ++bj)
#pragma unroll
                    for (int n = 0; n < 2; ++n) {
                        const f32x4 b = *(const f32x4*)(base + off + bj * 128 + n * 16);
                        *(f32x4*)(out + off + bj * 128 + n * 16) = b + acc[ai][bj][m][n] * sc[bj][n];
                    }
                if (m & 1) asm volatile("" ::: "memory");
            }
    }
};
__device__ __forceinline__ f32x4 bf_lo4(unsigned a, unsigned b) { return (f32x4){__uint_as_float(a << 16), __uint_as_float(a & 0xffff0000u), __uint_as_float(b << 16), __uint_as_float(b & 0xffff0000u)}; }
template <bool HALF_STEP, int PM_MASK> struct EpiResidB {
    static constexpr bool PERM = true, AFTER_DRAIN = false;
    const float* base32; const bf16_t* base16; bf16_t* out; const float* scale;
    __device__ __forceinline__ void operator()(const f32x4 (&acc)[2][2][4][2], const Unit& u, int wr, int wc, int fr, int fq) const {
        constexpr float alpha = HALF_STEP ? 0.5f : 1.0f;
        const int row0 = (u.pm & PM_MASK) * 256 + wr * 64 + fr, col0 = u.pn * 256 + wc * 32 + 8 * fq;
        f32x4 sc[2][2];
#pragma unroll
        for (int bj = 0; bj < 2; ++bj)
#pragma unroll
            for (int n = 0; n < 2; ++n) { sc[bj][n] = (f32x4){alpha, alpha, alpha, alpha}; if (scale) sc[bj][n] = sc[bj][n] * *(const f32x4*)(scale + col0 + bj * 128 + 4 * n); }
#pragma unroll
        for (int ai = 0; ai < 2; ++ai)
#pragma unroll
            for (int m = 0; m < 4; ++m) {
                const size_t off = (size_t)(row0 + ai * 128 + m * 16) * D + col0;
#pragma unroll
                for (int bj = 0; bj < 2; ++bj) {
                    f32x4 b0, b1;
                    if (base32) { b0 = *(const f32x4*)(base32 + off + bj * 128); b1 = *(const f32x4*)(base32 + off + bj * 128 + 4); }
                    else { const u32x4 w = *(const u32x4*)(base16 + off + bj * 128); b0 = bf_lo4(w.x, w.y); b1 = bf_lo4(w.z, w.w); }
                    const f32x4 v0 = b0 + acc[ai][bj][m][0] * sc[bj][0], v1 = b1 + acc[ai][bj][m][1] * sc[bj][1];
                    u32x4 o; o.x = pk2(v0.x, v0.y); o.y = pk2(v0.z, v0.w); o.z = pk2(v1.x, v1.y); o.w = pk2(v1.z, v1.w);
                    *(u32x4*)(out + off + bj * 128) = o;
                }
                if (m & 1) asm volatile("" ::: "memory");
            }
    }
};
struct EpiF32 {
    static constexpr bool PERM = false, AFTER_DRAIN = false;
    float* O;
    __device__ __forceinline__ void operator()(const f32x4 (&acc)[2][2][4][2], const Unit& u, int wr, int wc, int fr, int fq) const {
        const int row0 = u.pm * 256 + wr * 64 + fr, col0 = wc * 32 + 4 * fq;
#pragma unroll
        for (int ai = 0; ai < 2; ++ai)
#pragma unroll
            for (int m = 0; m < 4; ++m)
#pragma unroll
                for (int bj = 0; bj < 2; ++bj)
#pragma unroll
                    for (int n = 0; n < 2; ++n) *(f32x4*)(O + (size_t)(row0 + ai * 128 + m * 16) * 256 + col0 + bj * 128 + n * 16) = acc[ai][bj][m][n];
    }
};
struct EpiCQ {
    static constexpr bool PERM = false, AFTER_DRAIN = false;
    bf16_t* O; float* ssq;
    __device__ __forceinline__ void operator()(const f32x4 (&acc)[2][2][4][2], const Unit& u, int wr, int wc, int fr, int fq) const {
        const int row0 = u.pm * 256 + wr * 64 + fr, col0 = wc * 32 + 4 * fq;
#pragma unroll
        for (int ai = 0; ai < 2; ++ai)
#pragma unroll
            for (int m = 0; m < 4; ++m) {
                const int row = row0 + ai * 128 + m * 16;
                float part = 0.f;
#pragma unroll
                for (int bj = 0; bj < 2; ++bj)
#pragma unroll
                    for (int n = 0; n < 2; ++n) { const f32x4 v = acc[ai][bj][m][n]; part += dot4(v, v);
                        u32x2 w; w.x = pk2(v.x, v.y); w.y = pk2(v.z, v.w); *(u32x2*)(O + (size_t)row * 256 + col0 + bj * 128 + n * 16) = w; }
                part += __shfl_xor(part, 16); part += __shfl_xor(part, 32);
                if (fq == 0) ssq[(size_t)row * 4 + wc] = part;
            }
    }
};
__device__ __forceinline__ float rstd4q(const float* ssq, int row) {
    const f32x4 a = *(const f32x4*)(ssq + (size_t)row * 4);
    return 1.0f / sqrtf(((a.x + a.y) + (a.z + a.w)) * (1.0f / 256.0f) + RMS_EPS); }
struct EpiQN {
    static constexpr bool PERM = true, AFTER_DRAIN = false;
    bf16_t* Q; const float* ssq;
    __device__ __forceinline__ void operator()(const f32x4 (&acc)[2][2][4][2], const Unit& u, int wr, int wc, int fr, int fq) const {
        const int row0 = u.pm * 256 + wr * 64 + fr;
#pragma unroll
        for (int ai = 0; ai < 2; ++ai)
#pragma unroll
            for (int m = 0; m < 4; ++m) {
                const float rs = rstd4q(ssq, row0 + ai * 128 + m * 16) * C2;
#pragma unroll
                for (int bj = 0; bj < 2; ++bj) {
                    const f32x4 v0 = acc[ai][bj][m][0] * rs, v1 = acc[ai][bj][m][1] * rs;
                    u32x4 w; w.x = pk2(v0.x, v0.y); w.y = pk2(v0.z, v0.w); w.z = pk2(v1.x, v1.y); w.w = pk2(v1.z, v1.w);
                    *(u32x4*)(Q + (size_t)(row0 + ai * 128 + m * 16) * 3072 + (2 * u.pn + bj) * 192 + wc * 32 + 8 * fq) = w;
                }
            }
    }
};
struct EpiQR {
    static constexpr bool PERM = true, AFTER_DRAIN = false;
    bf16_t* Q; const float* COS; const float* SIN; const float* ssq;
    __device__ __forceinline__ void operator()(const f32x4 (&acc)[2][2][4][2], const Unit& u, int wr, int wc, int fr, int fq) const {
        const int row0 = u.pm * 256 + wr * 64 + fr;
        const int head = 4 * u.pn + wc, i0 = 8 * fq;
#pragma unroll
        for (int ai = 0; ai < 2; ++ai)
#pragma unroll
            for (int m = 0; m < 4; ++m) {
                const int row = row0 + ai * 128 + m * 16, pos = row & (S - 1);
                const f32x4 c0 = *(const f32x4*)(COS + pos * 32 + i0), c1 = *(const f32x4*)(COS + pos * 32 + i0 + 4);
                const f32x4 s0 = *(const f32x4*)(SIN + pos * 32 + i0), s1 = *(const f32x4*)(SIN + pos * 32 + i0 + 4);
                const f32x4 x1a = acc[ai][0][m][0], x1b = acc[ai][0][m][1], x2a = acc[ai][1][m][0], x2b = acc[ai][1][m][1];
                const float rs = rstd4q(ssq, row) * C2;
                const f32x4 o1a = (x1a * c0 - x2a * s0) * rs, o1b = (x1b * c1 - x2b * s1) * rs;
                const f32x4 o2a = (x1a * s0 + x2a * c0) * rs, o2b = (x1b * s1 + x2b * c1) * rs;
                bf16_t* qp = Q + (size_t)row * 3072 + head * 192 + 128 + i0;
                u32x4 w; w.x = pk2(o1a.x, o1a.y); w.y = pk2(o1a.z, o1a.w); w.z = pk2(o1b.x, o1b.y); w.w = pk2(o1b.z, o1b.w);
                *(u32x4*)qp = w;
                w.x = pk2(o2a.x, o2a.y); w.y = pk2(o2a.z, o2a.w); w.z = pk2(o2b.x, o2b.y); w.w = pk2(o2b.z, o2b.w);
                *(u32x4*)(qp + 32) = w;
                asm volatile("" ::: "memory");
            }
    }
};
struct PoolOrder {
    int G, c;
    __device__ __forceinline__ bool next(int i, Unit& u) const { const int L = i * G + c; if (L >= 4 * (T / 256)) return false; u.pm = L; u.pn = L >> 7; return true; }
    __device__ __forceinline__ void a_ready(const Unit&) const {}
    __device__ __forceinline__ void done(const Unit&) const {}
};

__device__ __forceinline__ void transpose_item(const float* __restrict__ W, int ldw, bf16_t* WT, int ldt, LAS float* scr, int k0, int n0, int r0, int lane, const float* gk = nullptr) {
#pragma unroll 8
    for (int i = 0; i < 32; ++i) { const int kk = 2 * i + (lane >> 5); scr[kk * 33 + (lane & 31)] = W[(size_t)(k0 + kk) * ldw + n0 + (lane & 31)] * (gk ? gk[k0 + kk] : 1.0f); }
    asm volatile("s_waitcnt lgkmcnt(0)" ::: "memory");
    const int c = lane & 7;
#pragma unroll
    for (int j = 0; j < 4; ++j) {
        const int n = (lane >> 3) + 8 * j; const LAS float* s = scr + (8 * c) * 33 + n;
        u32x4 o; o.x = pk2(s[0 * 33], s[1 * 33]); o.y = pk2(s[2 * 33], s[3 * 33]); o.z = pk2(s[4 * 33], s[5 * 33]); o.w = pk2(s[6 * 33], s[7 * 33]);
        *(u32x4*)(WT + (size_t)(r0 + n) * ldt + k0 + 8 * c) = o;
    }
    asm volatile("s_waitcnt lgkmcnt(0)" ::: "memory");
}

__device__ __forceinline__ void norm_phase(const float* src, const float* gain, bf16_t* dst, int gw, int NGW, int lane) {
    f32x4 g[4];
#pragma unroll
    for (int j = 0; j < 4; ++j) g[j] = ((const f32x4*)gain)[lane + 64 * j];
    for (int m = gw; m < T; m += NGW) {
        const f32x4* xr = (const f32x4*)(src + (size_t)m * D) + lane;
        f32x4 v[4]; float s = 0.f;
#pragma unroll
        for (int j = 0; j < 4; ++j) { v[j] = xr[64 * j]; s += dot4(v[j], v[j]); }
        const float rstd = 1.0f / sqrtf(wave_sum(s) * (1.0f / D) + RMS_EPS);
        u32x2* o8 = (u32x2*)(dst + (size_t)m * D) + lane;
#pragma unroll
        for (int j = 0; j < 4; ++j) { const f32x4 o = v[j] * rstd * g[j]; u32x2 w; w.x = pk2(o.x, o.y); w.y = pk2(o.z, o.w); o8[64 * j] = w; }
    }
}
__device__ __forceinline__ void norm_phase16(const bf16_t* src, const float* gain, bf16_t* dst, int gw, int NGW, int lane) {
    f32x4 g[4];
    g[0] = *(const f32x4*)(gain + 8 * lane); g[1] = *(const f32x4*)(gain + 8 * lane + 4); g[2] = *(const f32x4*)(gain + 512 + 8 * lane); g[3] = *(const f32x4*)(gain + 512 + 8 * lane + 4);
    for (int m0 = gw; m0 < T; m0 += 4 * NGW) {
        u32x4 wa[4], wb[4];
#pragma unroll
        for (int q = 0; q < 4; ++q) { const int m = m0 + q * NGW; if (m < T) { wa[q] = *(const u32x4*)(src + (size_t)m * D + 8 * lane); wb[q] = *(const u32x4*)(src + (size_t)m * D + 512 + 8 * lane); } }
#pragma unroll
        for (int q = 0; q < 4; ++q) { const int m = m0 + q * NGW; if (m < T) {
            f32x4 v[4]; v[0] = bf_lo4(wa[q].x, wa[q].y); v[1] = bf_lo4(wa[q].z, wa[q].w); v[2] = bf_lo4(wb[q].x, wb[q].y); v[3] = bf_lo4(wb[q].z, wb[q].w);
            float s = 0.f;
#pragma unroll
            for (int j = 0; j < 4; ++j) s += dot4(v[j], v[j]);
            const float rstd = 1.0f / sqrtf(wave_sum(s) * (1.0f / D) + RMS_EPS);
            u32x4 oa, ob;
            { const f32x4 a = v[0] * rstd * g[0], b = v[1] * rstd * g[1]; oa.x = pk2(a.x, a.y); oa.y = pk2(a.z, a.w); oa.z = pk2(b.x, b.y); oa.w = pk2(b.z, b.w); }
            { const f32x4 a = v[2] * rstd * g[2], b = v[3] * rstd * g[3]; ob.x = pk2(a.x, a.y); ob.y = pk2(a.z, a.w); ob.z = pk2(b.x, b.y); ob.w = pk2(b.z, b.w); }
            *(u32x4*)(dst + (size_t)m * D + 8 * lane) = oa; *(u32x4*)(dst + (size_t)m * D + 512 + 8 * lane) = ob; } }
    }
}
__device__ __forceinline__ void final_norm_phase(float* io, const float* gain, int gw, int NGW, int lane) {
    f32x4 g[4];
#pragma unroll
    for (int j = 0; j < 4; ++j) g[j] = ((const f32x4*)gain)[lane + 64 * j];
    for (int m = gw; m < T; m += NGW) {
        f32x4* xr = (f32x4*)(io + (size_t)m * D) + lane;
        f32x4 v[4]; float s = 0.f;
#pragma unroll
        for (int j = 0; j < 4; ++j) { v[j] = xr[64 * j]; s += dot4(v[j], v[j]); }
        const float rstd = 1.0f / sqrtf(wave_sum(s) * (1.0f / D) + RMS_EPS);
#pragma unroll
        for (int j = 0; j < 4; ++j) xr[64 * j] = v[j] * rstd * g[j];
    }
}
__device__ __forceinline__ void cq_norm_phase(const float* RAW, const float* gain, bf16_t* CQ, int gw, int NGW, int lane) {
    const f32x4 g = ((const f32x4*)gain)[lane];
    for (int m = gw; m < T; m += NGW) {
        const f32x4 v = ((const f32x4*)(RAW + (size_t)m * 256))[lane];
        const float rstd = 1.0f / sqrtf(wave_sum(dot4(v, v)) * (1.0f / 256.0f) + RMS_EPS);
        const f32x4 o = v * rstd * g; u32x2 w; w.x = pk2(o.x, o.y); w.y = pk2(o.z, o.w);
        ((u32x2*)(CQ + (size_t)m * 256))[lane] = w;
    }
}
__device__ __forceinline__ unsigned off_b(unsigned row, unsigned ch) { return 2048u * (row >> 3) + 512u * (ch >> 2) + 64u * (row & 7) + 16u * ((ch & 3) ^ ((row >> 2) & 3)); }
__device__ __forceinline__ unsigned off_r(unsigned row, unsigned ch) { return 8192u + 128u * row + 16u * (ch ^ ((row >> 1) & 7)); }
__device__ __forceinline__ void kv_prep_phase(const float* RAW, const float* ckv_gain, const float* COS, const float* SIN, unsigned char* KIMG, int gw, int NGW, int lane) {
    const f32x4 g = ((const f32x4*)ckv_gain)[lane & 31];
    for (int m = gw; m < T; m += NGW) {
        const f32x4 v = ((const f32x4*)(RAW + (size_t)m * 256))[lane];
        const float ss = wave_sum(lane < 32 ? dot4(v, v) : 0.f);
        const float rstd = 1.0f / sqrtf(ss * (1.0f / 128.0f) + RMS_EPS);
        const int tt = m & (S - 1), b = m >> 14, tile = tt >> 6, kb = (tt >> 5) & 1, row = tt & 31;
        unsigned char* base = KIMG + ((size_t)(b * 256 + tile)) * 24576 + kb * 12288;
        f32x4 other; other.x = __shfl_xor(v.x, 8); other.y = __shfl_xor(v.y, 8); other.z = __shfl_xor(v.z, 8); other.w = __shfl_xor(v.w, 8);
        if (lane < 32) {
            const f32x4 o = v * rstd * g; u32x2 w; w.x = pk2(o.x, o.y); w.y = pk2(o.z, o.w);
            *(u32x2*)(base + off_b(row, lane >> 1) + 8 * (lane & 1)) = w;
        } else if (lane < 48) {
            const int i0 = 4 * (lane & 7); const bool second = lane >= 40;
            const f32x4 c = *(const f32x4*)(COS + tt * 32 + i0), s = *(const f32x4*)(SIN + tt * 32 + i0);
            const f32x4 x1 = second ? other : v, x2 = second ? v : other;
            const f32x4 o = second ? (x1 * s + x2 * c) : (x1 * c - x2 * s);
            const int cr = (second ? 32 : 0) + i0;
            u32x2 w; w.x = pk2(o.x, o.y); w.y = pk2(o.z, o.w);
            *(u32x2*)(base + off_r(row, cr >> 3) + 8 * ((cr >> 2) & 1)) = w;
        }
    }
}
template <int W> __device__ __forceinline__ void pool_rows(const bf16_t* H, const float* gain, bf16_t* Y, const LAS float* rs, int t0, int bstart, int g, int oct, int tq) {
    constexpr int NR = 16 + W - 1;
    const int c0 = g * 256 + oct * 8, tb = t0 + 16 * tq;
    u32x4 raw[NR];
#pragma unroll
    for (int k = 0; k < NR; ++k) { const int t = tb - (W - 1) + k; raw[k] = (t >= bstart) ? *(const u32x4*)(H + (size_t)t * D + c0) : (u32x4){0u, 0u, 0u, 0u}; }
    const f32x4 g0 = *(const f32x4*)(gain + c0), g1 = *(const f32x4*)(gain + c0 + 4);
    f32x4 s0 = {0.f, 0.f, 0.f, 0.f}, s1 = {0.f, 0.f, 0.f, 0.f};
#pragma unroll
    for (int k = 0; k < NR; ++k) {
        const int t = tb - (W - 1) + k;
        const float r = rs[t - (t0 - 16)];
        const f32x4 u0 = bf_lo4(raw[k].x, raw[k].y) * r * g0, u1 = bf_lo4(raw[k].z, raw[k].w) * r * g1;
        s0 = s0 + u0; s1 = s1 + u1;
        if (k >= W) { const float ro = rs[t - W - (t0 - 16)];
            u32x4 old = raw[k - W]; asm volatile("" : "+v"(old));
            s0 = s0 - bf_lo4(old.x, old.y) * ro * g0; s1 = s1 - bf_lo4(old.z, old.w) * ro * g1; }
        if (k >= W - 1) {
            const int cnt = min(t - bstart + 1, W); const float ic = 1.0f / (float)cnt;
            const f32x4 y0 = s0 * ic - u0, y1 = s1 * ic - u1;
            u32x4 w; w.x = pk2(y0.x, y0.y); w.y = pk2(y0.z, y0.w); w.z = pk2(y1.x, y1.y); w.w = pk2(y1.z, y1.w);
            *(u32x4*)(Y + ((size_t)g * T + t) * 256 + oct * 8) = w;
        }
    }
}
__device__ __forceinline__ void pool_y_phase(const bf16_t* H, const float* gain, bf16_t* Y, LAS float* rs, int bid, int G, int tid, int lane, int wave) {
    for (int chunk = bid; chunk < T / 64; chunk += G) {
        const int t0 = chunk * 64, bstart = (t0 >> 14) << 14;
        for (int rr = wave; rr < 80; rr += NWAVES) {
            const int t = t0 - 16 + rr;
            float rstd = 0.f;
            if (t >= bstart) {
                const u32x4 wa = *(const u32x4*)(H + (size_t)t * D + 8 * lane), wb = *(const u32x4*)(H + (size_t)t * D + 512 + 8 * lane);
                const f32x4 a = bf_lo4(wa.x, wa.y), b = bf_lo4(wa.z, wa.w), c = bf_lo4(wb.x, wb.y), d = bf_lo4(wb.z, wb.w);
                rstd = 1.0f / sqrtf(wave_sum((dot4(a, a) + dot4(b, b)) + (dot4(c, c) + dot4(d, d))) * (1.0f / D) + RMS_EPS);
            }
            if (lane == 0) rs[rr] = rstd;
        }
        __syncthreads();
        {
            const int g = wave >> 1, idx = (wave & 1) * 64 + lane, oct = idx & 31, tq = idx >> 5;
            if (g == 0) pool_rows<2>(H, gain, Y, rs, t0, bstart, 0, oct, tq);
            else if (g == 1) pool_rows<4>(H, gain, Y, rs, t0, bstart, 1, oct, tq);
            else if (g == 2) pool_rows<8>(H, gain, Y, rs, t0, bstart, 2, oct, tq);
            else pool_rows<16>(H, gain, Y, rs, t0, bstart, 3, oct, tq);
        }
        __syncthreads();
    }
}

__device__ __forceinline__ int crow(int r, int hi) { return (r & 3) + 8 * (r >> 2) + 4 * hi; }
__device__ __forceinline__ bf16x8 pack8(const f32x16& x, int s) {
    u32x4 p; p.x = pk2(x[8 * s], x[8 * s + 1]); p.y = pk2(x[8 * s + 2], x[8 * s + 3]); p.z = pk2(x[8 * s + 4], x[8 * s + 5]); p.w = pk2(x[8 * s + 6], x[8 * s + 7]);
    return __builtin_bit_cast(bf16x8, p);
}
__device__ __forceinline__ void glds16(const void* gsrc, unsigned lds_dst) { unsigned keep;
    asm volatile("s_mov_b32 %0, m0\n\ts_mov_b32 m0, %2\n\ts_nop 0\n\tglobal_load_lds_dwordx4 %1, off\n\ts_mov_b32 m0, %0" : "=&s"(keep) : "v"(gsrc), "s"(lds_dst) : "memory"); }
#define SCHEDB() __builtin_amdgcn_sched_barrier(0)
#define H_LOAD(kb, g, dst) do { _Pragma("unroll") for (int e_ = 0; e_ < 4; ++e_) { const int s_ = 4 * (g) + e_; \
        if (s_ < 8) dst[e_] = *(const LAS bf16x8*)(lds + ka[s_ & 1] + (512 * (s_ >> 1) + 12288 * (kb))); \
        else        dst[e_] = *(const LAS bf16x8*)(lds + kr[s_ - 8] + (8192 + 12288 * (kb))); } } while (0)
#define H_MMA(S, g, src) do { _Pragma("unroll") for (int e_ = 0; e_ < 4; ++e_) S = __builtin_amdgcn_mfma_f32_32x32x16_bf16(src[e_], qf[4 * (g) + e_], S, 0, 0, 0); } while (0)
#define HV_LOAD(h, c, dst) do { _Pragma("unroll") for (int k_ = 0; k_ < 2; ++k_) { \
        dst[2 * k_] = __builtin_amdgcn_ds_read_tr16_b64_v4i16((LAS s16x4*)(lds + va[0] + ((h) * 12288 + k_ * 4096 + 512 * (c)))); \
        dst[2 * k_ + 1] = __builtin_amdgcn_ds_read_tr16_b64_v4i16((LAS s16x4*)(lds + va[1] + ((h) * 12288 + k_ * 4096 + 2048 + 512 * (c)))); } } while (0)
#define HV_MMA(h, c, src) do { _Pragma("unroll") for (int k_ = 0; k_ < 2; ++k_) { \
        const bf16x8 vf_ = __builtin_shufflevector(src[2 * k_], src[2 * k_ + 1], 0, 1, 2, 3, 4, 5, 6, 7); \
        o[c] = __builtin_amdgcn_mfma_f32_32x32x16_bf16(vf_, pf[2 * (h) + k_], o[c], 0, 0, 0); } } while (0)
#define EXP8_PIN(S, lo) do { float e_[8]; _Pragma("unroll") for (int r_ = 0; r_ < 8; ++r_) e_[r_] = __builtin_amdgcn_exp2f(S[(lo) + r_]); \
        asm volatile("" : "+v"(e_[0]), "+v"(e_[1]), "+v"(e_[2]), "+v"(e_[3]), "+v"(e_[4]), "+v"(e_[5]), "+v"(e_[6]), "+v"(e_[7])); \
        _Pragma("unroll") for (int r_ = 0; r_ < 8; ++r_) S[(lo) + r_] = e_[r_]; } while (0)
__device__ __forceinline__ float half_max(const f32x16& x) {
    float m = fmaxf(fmaxf(x[0], x[1]), x[2]);
#pragma unroll
    for (int r = 3; r < 15; r += 2) m = fmaxf(fmaxf(m, x[r]), x[r + 1]);
    m = fmaxf(m, x[15]);
    return fmaxf(m, __shfl_xor(m, 32));
}
__device__ __forceinline__ bf16x8 scale_pf(bf16x8 p, float sc) {
    u32x4 u = __builtin_bit_cast(u32x4, p); u32x4 r;
#pragma unroll
    for (int i = 0; i < 4; ++i) { const float lo = __uint_as_float(u[i] << 16) * sc, hi = __uint_as_float(u[i] & 0xffff0000u) * sc; r[i] = pk2(lo, hi); }
    return __builtin_bit_cast(bf16x8, r);
}
__device__ __forceinline__ void attn_tile2(LAS unsigned char* lds, const bf16x8 (&qf)[12], f32x16& negm, f32x16 (&o)[4], float& mref, float& lsum,
                                           const unsigned (&ka)[2], const unsigned (&kr)[4], const unsigned (&va)[2], bool first, bool last, int qpos, int kb0) {
    f32x16 s0, s1;
    bf16x8 A0[4], A1[4], pf[4];
    s16x4 V0[4], V1[4];
    H_LOAD(0, 0, A0); H_LOAD(0, 1, A1);
    __builtin_amdgcn_s_setprio(1);
    SCHEDB();
    s0 = __builtin_amdgcn_mfma_f32_32x32x16_bf16(A0[0], qf[0], negm, 0, 0, 0);
#pragma unroll
    for (int e = 1; e < 4; ++e) s0 = __builtin_amdgcn_mfma_f32_32x32x16_bf16(A0[e], qf[e], s0, 0, 0, 0);
    SCHEDB();
    H_LOAD(0, 2, A0); SCHEDB();
    H_MMA(s0, 1, A1); SCHEDB();
    H_LOAD(1, 0, A1); SCHEDB();
    H_MMA(s0, 2, A0); SCHEDB();
    __builtin_amdgcn_s_setprio(0);
    H_LOAD(1, 1, A0);
    if (last) {
        int ln = (int)__builtin_amdgcn_mbcnt_hi(~0u, __builtin_amdgcn_mbcnt_lo(~0u, 0u)); asm volatile("" : "+v"(ln));
        const int qp_ = qpos + (ln & 31), hi_ = ln >> 5;
#pragma unroll
        for (int r = 0; r < 16; ++r) { const int key = kb0 + crow(r, hi_); if (key > qp_) s0[r] = -INFINITY; }
    }
    {
        const float mx = half_max(s0);
        const bool need = (mx > 8.0f) || first;
        if (__builtin_amdgcn_ballot_w64(need) != 0ull) {
            const float dl = need ? mx : 0.f;
            const float sc = first ? 0.f : __builtin_amdgcn_exp2f(-dl);
            mref += dl; lsum *= sc;
#pragma unroll
            for (int r = 0; r < 16; ++r) { s0[r] -= dl; negm[r] = -mref; }
#pragma unroll
            for (int c = 0; c < 4; ++c)
#pragma unroll
                for (int r = 0; r < 16; ++r) o[c][r] *= sc;
        }
    }
    SCHEDB();
    __builtin_amdgcn_s_setprio(1);
    s1 = __builtin_amdgcn_mfma_f32_32x32x16_bf16(A1[0], qf[0], negm, 0, 0, 0);
#pragma unroll
    for (int e = 1; e < 4; ++e) s1 = __builtin_amdgcn_mfma_f32_32x32x16_bf16(A1[e], qf[e], s1, 0, 0, 0);
    EXP8_PIN(s0, 0);
    SCHEDB();
    H_LOAD(1, 2, A1); SCHEDB();
    H_MMA(s1, 1, A0);
    EXP8_PIN(s0, 8);
    SCHEDB();
    HV_LOAD(0, 0, V0); SCHEDB();
    H_MMA(s1, 2, A1);
    { float rs = 0.f;
#pragma unroll
      for (int r = 0; r < 16; ++r) rs += s0[r];
      lsum += rs; }
    pf[0] = pack8(s0, 0); pf[1] = pack8(s0, 1);
    asm volatile("" : "+v"(lsum));
    SCHEDB();
    __builtin_amdgcn_s_setprio(0);
    if (last) {
        int ln = (int)__builtin_amdgcn_mbcnt_hi(~0u, __builtin_amdgcn_mbcnt_lo(~0u, 0u)); asm volatile("" : "+v"(ln));
        const int qp_ = qpos + (ln & 31), hi_ = ln >> 5;
#pragma unroll
        for (int r = 0; r < 16; ++r) { const int key = kb0 + 32 + crow(r, hi_); if (key > qp_) s1[r] = -INFINITY; }
    }
    {
        const float mx = half_max(s1);
        const bool need = mx > 8.0f;
        if (__builtin_amdgcn_ballot_w64(need) != 0ull) {
            const float dl = need ? mx : 0.f;
            const float sc = __builtin_amdgcn_exp2f(-dl);
            mref += dl; lsum *= sc;
#pragma unroll
            for (int r = 0; r < 16; ++r) { s1[r] -= dl; negm[r] = -mref; }
#pragma unroll
            for (int c = 0; c < 4; ++c)
#pragma unroll
                for (int r = 0; r < 16; ++r) o[c][r] *= sc;
            pf[0] = scale_pf(pf[0], sc); pf[1] = scale_pf(pf[1], sc);
        }
    }
    SCHEDB();
    __builtin_amdgcn_s_setprio(1);
    HV_LOAD(0, 1, V1); SCHEDB();
    HV_MMA(0, 0, V0);
#pragma unroll
    for (int r = 0; r < 6; ++r) s1[r] = __builtin_amdgcn_exp2f(s1[r]);
    SCHEDB();
    HV_LOAD(0, 2, V0); SCHEDB();
    HV_MMA(0, 1, V1);
#pragma unroll
    for (int r = 6; r < 12; ++r) s1[r] = __builtin_amdgcn_exp2f(s1[r]);
    SCHEDB();
    HV_LOAD(0, 3, V1); SCHEDB();
    HV_MMA(0, 2, V0);
#pragma unroll
    for (int r = 12; r < 16; ++r) s1[r] = __builtin_amdgcn_exp2f(s1[r]);
    SCHEDB();
    HV_LOAD(1, 0, V0); SCHEDB();
    HV_MMA(0, 3, V1);
    { float rs = 0.f;
#pragma unroll
      for (int r = 0; r < 16; ++r) rs += s1[r];
      lsum += rs; }
    pf[2] = pack8(s1, 0); pf[3] = pack8(s1, 1);
    SCHEDB();
    HV_LOAD(1, 1, V1); SCHEDB(); HV_MMA(1, 0, V0); SCHEDB();
    HV_LOAD(1, 2, V0); SCHEDB(); HV_MMA(1, 1, V1); SCHEDB();
    HV_LOAD(1, 3, V1); SCHEDB(); HV_MMA(1, 2, V0); SCHEDB();
    HV_MMA(1, 3, V1); SCHEDB();
    __builtin_amdgcn_s_setprio(0);
}
__device__ __forceinline__ void attn_phase(LAS unsigned char* lds, const bf16_t* __restrict__ Q, const unsigned char* __restrict__ KIMG, bf16_t* __restrict__ OL, int bid, int G, int tid, int lane, int wave) {
    const int r32 = lane & 31, hi = lane >> 5;
    const unsigned ldsbase = (unsigned)(uintptr_t)lds;
    const unsigned th = lane >> 5, tblk = (lane >> 4) & 1, tq = (lane & 15) >> 2, tp = lane & 3;
    const unsigned kbase = 2048u * (r32 >> 3) + 64u * (r32 & 7) + 16u * (hi ^ ((r32 >> 2) & 3)), rbase = 128u * r32 + 16u * (hi ^ ((r32 >> 1) & 7));
    const unsigned vbase = 64u * (4 * th + tq) + 16u * ((2 * tblk + (tp >> 1)) ^ th) + 8u * (tp & 1);
#define ATT_WAITV(n) asm volatile("s_waitcnt vmcnt(" #n ")" ::: "memory")
#define ATT_BAR() do { asm volatile("" ::: "memory"); __builtin_amdgcn_s_barrier(); asm volatile("" ::: "memory"); } while (0)
    for (int j = 0;; ++j) {
        const int u = j * G + ((j & 1) ? (G - 1 - bid) : bid);
        if (u >= 2048) break;
        const int i = 511 - (u >> 2), b = (u >> 1) & 1, hg = u & 1;
        const int head = hg * 8 + wave, r0 = i * 32, NT = (r0 + 31) / 64 + 1;
        const bf16_t* qp = Q + ((size_t)(b * S + r0 + r32)) * 3072 + head * 192 + hi * 8;
        bf16x8 qf[12];
#pragma unroll
        for (int s = 0; s < 12; ++s) qf[s] = *(const bf16x8*)(qp + 16 * s);
        f32x16 o[4];
#pragma unroll
        for (int c = 0; c < 4; ++c)
#pragma unroll
            for (int r = 0; r < 16; ++r) o[c][r] = 0.f;
        float mref = 0.f, lsum = 0.f;
        f32x16 negm;
#pragma unroll
        for (int r = 0; r < 16; ++r) negm[r] = 0.f;
        unsigned kcur = kbase, rcur = rbase, vcur = vbase;
        const unsigned char* kt = KIMG + (size_t)(b * 256) * 24576;
        const int qpos = r0 + r32;
#define ATT_STAGE(tile, bufi) do { unsigned l16_ = (unsigned)__builtin_amdgcn_mbcnt_hi(~0u, __builtin_amdgcn_mbcnt_lo(~0u, 0u)) * 16u; asm volatile("" : "+v"(l16_));   \
        _Pragma("unroll") for (int c_ = 0; c_ < 3; ++c_) { const int ch_ = wave + 8 * c_; \
            glds16(kt + (size_t)(tile) * 24576 + ch_ * 1024 + l16_, (unsigned)__builtin_amdgcn_readfirstlane((int)(ldsbase + (bufi) * 24576 + ch_ * 1024))); } } while (0)
        ATT_STAGE(0, 0);
        if (NT > 1) ATT_STAGE(1, 1);
        ATT_WAITV(0);
        ATT_BAR();
#define ATT_ADV(dd) do { kcur += (dd); rcur += (dd); vcur += (dd); } while (0)
#define ATT_TILE(FIRST, LAST, KB0) do { const unsigned ka[2] = {kcur, kcur ^ 32u}, kr[4] = {rcur, rcur ^ 32u, rcur ^ 64u, rcur ^ 96u}, va[2] = {vcur, vcur ^ 32u}; \
            attn_tile2(lds, qf, negm, o, mref, lsum, ka, kr, va, (FIRST), (LAST), r0, (KB0)); } while (0)
        for (int t = 0; t < NT; t += 2) {
            const int nslot = (t & 2) ? 0 : 2;
            if (t + 2 < NT) ATT_STAGE(t + 2, nslot);
            if (t + 3 < NT) ATT_STAGE(t + 3, nslot + 1);
            ATT_TILE(t == 0, t == NT - 1, t * 64);
            ATT_ADV(24576);
            if (t + 1 < NT) ATT_TILE(false, t + 1 == NT - 1, (t + 1) * 64);
            ATT_WAITV(0);
            ATT_BAR();
            if (t & 2) ATT_ADV(-73728); else ATT_ADV(24576);
        }
        const float inv = 1.0f / (lsum + __shfl_xor(lsum, 32));
        LAS unsigned char* stg = lds + 49152 + wave * 8704;
        int ln = (int)__builtin_amdgcn_mbcnt_hi(~0u, __builtin_amdgcn_mbcnt_lo(~0u, 0u)); asm volatile("" : "+v"(ln));
        const int r32e = ln & 31, hie = ln >> 5;
#pragma unroll
        for (int c = 0; c < 4; ++c)
#pragma unroll
            for (int g4 = 0; g4 < 4; ++g4) {
                u32x2 w; w.x = pk2(o[c][4 * g4] * inv, o[c][4 * g4 + 1] * inv); w.y = pk2(o[c][4 * g4 + 2] * inv, o[c][4 * g4 + 3] * inv);
                *(LAS u32x2*)(stg + r32e * 272 + (32 * c + 8 * g4 + 4 * hie) * 2) = w;
            }
        asm volatile("s_waitcnt lgkmcnt(0)" ::: "memory");
        bf16_t* orow = OL + ((size_t)(b * S + r0)) * 2048 + head * 128;
#pragma unroll
        for (int k = 0; k < 8; ++k) {
            const int row = 4 * k + (ln >> 4), ch = ln & 15;
            const u32x4 v = *(const LAS u32x4*)(stg + row * 272 + ch * 16);
            *(u32x4*)(orow + (size_t)row * 2048 + ch * 8) = v;
        }
    }
}

struct Args { const float* in[22]; float* out; unsigned char* ws; };

__device__ __forceinline__ void prologue_phase(const __attribute__((address_space(4))) Args* a, LAS unsigned char* lds, int gw, int NGW, int lane, int wave, int tid, int bid, int G) {
    unsigned char* ws = a->ws;
    LAS float* scr = (LAS float*)(lds + wave * 8448);
    constexpr int IT_G = 8 * 16 * 88, IT_D = 8 * 44 * 32, IT_P = 8 * 4 * 8, IT_KV = 16 * 6, IT_DQ = 2 * 16 * 8, IT_UQR = 2 * 4 * 32;
    constexpr int NITEMS = 2 * IT_G + IT_D + IT_P + IT_KV + IT_DQ + IT_UQR;
    for (int it0 = gw; it0 < NITEMS; it0 += NGW) {
        int it = it0;
        if (it < 2 * IT_G) {
            const int up = it >= IT_G; if (up) it -= IT_G;
            const int f = it / 1408, rem = it % 1408, kb = rem / 88, nb = rem % 88, n0 = nb * 32;
            const float* src = ((f & 1) ? (up ? a->in[8] : a->in[7]) : (up ? a->in[3] : a->in[2])) + (size_t)(f >> 1) * D * FF;
            transpose_item(src, FF, (bf16_t*)(ws + WS_WGU + (size_t)f * SZ_WGU), D, scr, kb * 64, n0, (n0 >> 7) * 256 + (n0 & 127) + (up ? 128 : 0), lane);
            continue;
        }
        it -= 2 * IT_G;
        if (it < IT_D) {
            const int f = it / 1408, rem = it % 1408, kb = rem / 32, nb = rem % 32;
            const float* src = ((f & 1) ? a->in[9] : a->in[4]) + (size_t)(f >> 1) * FF * D;
            transpose_item(src, D, (bf16_t*)(ws + WS_WD + (size_t)f * SZ_WD), FF, scr, kb * 64, nb * 32, nb * 32, lane);
            continue;
        }
        it -= IT_D;
        if (it < IT_P) {
            const int lg = it / 32, rem = it % 32, kb = rem / 8, nb = rem % 8;
            transpose_item(a->in[10] + (size_t)lg * 65536, 256, (bf16_t*)(ws + WS_WP + (size_t)(lg >> 2) * SZ_WP), 256, scr, kb * 64, nb * 32, (lg & 3) * 256 + nb * 32, lane);
            continue;
        }
        it -= IT_P;
        if (it < IT_KV) {
            const int kb = it / 6, nb = it % 6;
            transpose_item(a->in[13], 192, (bf16_t*)(ws + WS_WDKV), D, scr, kb * 64, nb * 32, nb * 32, lane);
            continue;
        }
        it -= IT_KV;
        if (it < IT_DQ) {
            const int jj = it / 128, rem = it % 128, kb = rem / 8, nb = rem % 8;
            transpose_item(a->in[18] + (size_t)jj * D * 256, 256, (bf16_t*)(ws + WS_WDQ + (size_t)jj * 524288), D, scr, kb * 64, nb * 32, nb * 32, lane);
            continue;
        }
        it -= IT_DQ;
        {
            const int jj = it / 128, rem = it % 128, kb = rem / 32, nb = rem % 32, head = nb >> 1, bj = nb & 1;
            transpose_item(a->in[19] + (size_t)jj * 256 * 3072, 3072, (bf16_t*)(ws + WS_WUQ + (size_t)jj * SZ_WUQ), 256, scr, kb * 64, head * 192 + 128 + 32 * bj,
                           2048 + (head >> 2) * 256 + bj * 128 + (head & 3) * 32, lane, a->in[17] + jj * 256);
        }
    }
    { u32x4* z = (u32x4*)(ws + WS_WDKV + (size_t)192 * D * 2); const u32x4 zz = {0u, 0u, 0u, 0u};
      for (int i = bid * NTHREADS + tid; i < 64 * D * 2 / 16; i += G * NTHREADS) z[i] = zz; }
    for (int it = gw; it < 1024; it += NGW) {
        const int jj = it >> 9, h = (it >> 5) & 15, rb = (it >> 2) & 7, lb = it & 3, r32 = lane & 31, hi = lane >> 5;
        const float* qa = a->in[19] + (size_t)jj * 256 * 3072 + ((size_t)(rb * 32 + r32) * 16 + h) * 192 + 8 * hi;
        const float* kb = a->in[15] + ((size_t)(lb * 32 + r32) * 16 + h) * 128 + 8 * hi;
        f32x4 av[8][2], bv[8][2];
#pragma unroll
        for (int s = 0; s < 8; ++s) { av[s][0] = *(const f32x4*)(qa + 16 * s); av[s][1] = *(const f32x4*)(qa + 16 * s + 4); bv[s][0] = *(const f32x4*)(kb + 16 * s); bv[s][1] = *(const f32x4*)(kb + 16 * s + 4); }
        f32x16 acc;
#pragma unroll
        for (int r = 0; r < 16; ++r) acc[r] = 0.f;
#pragma unroll
        for (int s = 0; s < 8; ++s) {
            u32x4 pa, pb;
            pa.x = pk2(av[s][0].x, av[s][0].y); pa.y = pk2(av[s][0].z, av[s][0].w); pa.z = pk2(av[s][1].x, av[s][1].y); pa.w = pk2(av[s][1].z, av[s][1].w);
            pb.x = pk2(bv[s][0].x, bv[s][0].y); pb.y = pk2(bv[s][0].z, bv[s][0].w); pb.z = pk2(bv[s][1].x, bv[s][1].y); pb.w = pk2(bv[s][1].z, bv[s][1].w);
            acc = __builtin_amdgcn_mfma_f32_32x32x16_bf16(__builtin_bit_cast(bf16x8, pa), __builtin_bit_cast(bf16x8, pb), acc, 0, 0, 0);
        }
        bf16_t* dst = (bf16_t*)(ws + WS_WUQ + (size_t)jj * SZ_WUQ) + (size_t)(h * 128 + lb * 32 + r32) * 256 + rb * 32 + 4 * hi;
#pragma unroll
        for (int g4 = 0; g4 < 4; ++g4) { const f32x4 gq = *(const f32x4*)(a->in[17] + jj * 256 + rb * 32 + 4 * hi + 8 * g4);
            u32x2 w; w.x = pk2(acc[4 * g4] * gq.x, acc[4 * g4 + 1] * gq.y); w.y = pk2(acc[4 * g4 + 2] * gq.z, acc[4 * g4 + 3] * gq.w); *(u32x2*)(dst + 8 * g4) = w; }
    }
    for (int it = gw; it < 4096; it += NGW) {
        const int jj = it >> 11, h = (it >> 7) & 15, lb = (it >> 5) & 3, nb = it & 31, r32 = lane & 31, hi = lane >> 5;
        const float* va = a->in[16] + ((size_t)(lb * 32 + r32) * 16 + h) * 128 + 8 * hi;
        const float* ob = a->in[20] + (size_t)jj * 2048 * 1024 + (size_t)(h * 128 + 8 * hi) * 1024 + nb * 32 + r32;
        f32x16 acc;
#pragma unroll
        for (int r = 0; r < 16; ++r) acc[r] = 0.f;
#pragma unroll 2
        for (int s = 0; s < 8; ++s) {
            const f32x4 a0 = *(const f32x4*)(va + 16 * s), a1 = *(const f32x4*)(va + 16 * s + 4);
            float bq[8];
#pragma unroll
            for (int q = 0; q < 8; ++q) bq[q] = ob[(size_t)(16 * s + q) * 1024];
            u32x4 pa, pb;
            pa.x = pk2(a0.x, a0.y); pa.y = pk2(a0.z, a0.w); pa.z = pk2(a1.x, a1.y); pa.w = pk2(a1.z, a1.w);
            pb.x = pk2(bq[0], bq[1]); pb.y = pk2(bq[2], bq[3]); pb.z = pk2(bq[4], bq[5]); pb.w = pk2(bq[6], bq[7]);
            acc = __builtin_amdgcn_mfma_f32_32x32x16_bf16(__builtin_bit_cast(bf16x8, pa), __builtin_bit_cast(bf16x8, pb), acc, 0, 0, 0);
        }
        bf16_t* dst = (bf16_t*)(ws + WS_WOV + (size_t)jj * SZ_WOV) + (size_t)(nb * 32 + r32) * 2048 + h * 128 + lb * 32 + 4 * hi;
#pragma unroll
        for (int g4 = 0; g4 < 4; ++g4) { u32x2 w; w.x = pk2(acc[4 * g4], acc[4 * g4 + 1]); w.y = pk2(acc[4 * g4 + 2], acc[4 * g4 + 3]); *(u32x2*)(dst + 8 * g4) = w; }
    }
    { float* COS = (float*)(ws + WS_COS); float* SIN = (float*)(ws + WS_SIN);
      for (int idx = bid * NTHREADS + tid; idx < S * 32; idx += G * NTHREADS) {
          const int pos = idx >> 5, i = idx & 31;
          const float invf = exp2f(-(float)i * (13.287712379549449f / 32.0f));
          const float ang = (float)pos * invf;
          double xr = (double)ang * 0.15915494309189535; xr -= __builtin_rint(xr);
          const float rev = (float)xr;
          COS[idx] = __builtin_amdgcn_cosf(rev); SIN[idx] = __builtin_amdgcn_sinf(rev);
      } }
    norm_phase(a->in[0], a->in[1], (bf16_t*)(ws + WS_R1), gw, NGW, lane);
}

constexpr size_t WS_BAR = WS_END;
constexpr size_t WS_SSQ = WS_END + 256;
__device__ __forceinline__ unsigned xcc_id() { return (unsigned)__builtin_amdgcn_s_getreg((3 << 11) | 20) & 0xFu; }
__device__ __forceinline__ void grid_bar(unsigned* bar, unsigned k, unsigned x, unsigned nloc, unsigned nx) {
    asm volatile("s_waitcnt vmcnt(0) lgkmcnt(0)" ::: "memory");
    __syncthreads();
    if (threadIdx.x == 0) {
        const unsigned old = __hip_atomic_fetch_add(bar + 16 + x, 1u, __ATOMIC_RELAXED, __HIP_MEMORY_SCOPE_AGENT);
        if (old + 1u == k * nloc) {
            __builtin_amdgcn_fence(__ATOMIC_RELEASE, "agent");
            asm volatile("s_waitcnt vmcnt(0)" ::: "memory");
            __hip_atomic_fetch_add(bar, 1u, __ATOMIC_RELAXED, __HIP_MEMORY_SCOPE_AGENT);
        }
        while (__hip_atomic_load(bar, __ATOMIC_RELAXED, __HIP_MEMORY_SCOPE_AGENT) < k * nx) __builtin_amdgcn_s_sleep(1);
        __builtin_amdgcn_fence(__ATOMIC_ACQUIRE, "agent");
        asm volatile("s_waitcnt vmcnt(0)" ::: "memory");
    }
    __syncthreads();
}
#define GSYNC() do { ++bar_k; grid_bar((unsigned*)(((ArgsP)__builtin_amdgcn_kernarg_segment_ptr())->ws + WS_BAR), (unsigned)bar_k, bar_x, bar_nloc, bar_nx); } while (0)
typedef const __attribute__((address_space(4))) Args* ArgsP;
#define PHASE_IDS() int tid = threadIdx.x; asm volatile("" : "+v"(tid)); const int lane = tid & 63, wave = __builtin_amdgcn_readfirstlane(tid >> 6); \
    int bid_l = blockIdx.x, G_l = gridDim.x; asm volatile("" : "+s"(bid_l), "+s"(G_l)); const int bid = bid_l, G = G_l, gw = bid * NWAVES + wave, NGW = G * NWAVES; \
    ArgsP ap = (ArgsP)__builtin_amdgcn_kernarg_segment_ptr(); asm volatile("" : "+s"(ap)); unsigned char* ws = ap->ws; float* Hout = ap->out; bf16_t* Hb = (bf16_t*)((unsigned char*)ap->out + 67108864);     \
    (void)lane; (void)gw; (void)NGW; (void)ws; (void)bid; (void)G; (void)Hout; (void)Hb;
__global__ void __launch_bounds__(NTHREADS, 2) yoco_fwd(Args a) {
    extern __shared__ __attribute__((aligned(16))) unsigned char lds_raw[];
    LAS unsigned char* lds = (LAS unsigned char*)lds_raw;
    const unsigned bar_x = xcc_id();
    if (threadIdx.x == 0) __hip_atomic_fetch_add((unsigned*)(a.ws + WS_BAR) + 32 + bar_x, 1u, __ATOMIC_RELAXED, __HIP_MEMORY_SCOPE_AGENT);
    { PHASE_IDS(); prologue_phase(ap, lds, gw, NGW, lane, wave, tid, bid, G); }
    cg::this_grid().sync();
    int bar_k = 0;
    unsigned bar_nloc = 1, bar_nx = 0;
    { const unsigned* cen = (const unsigned*)(a.ws + WS_BAR) + 32;
#pragma unroll
      for (unsigned j = 0; j < 16; ++j) { const unsigned c = __hip_atomic_load(cen + j, __ATOMIC_RELAXED, __HIP_MEMORY_SCOPE_AGENT); bar_nx += (c > 0u) ? 1u : 0u; if (j == bar_x) bar_nloc = c; } }
    for (int f = 0; f < 8; ++f) {
        const int l = f >> 1;
        { PHASE_IDS(); pg8::Gemm g{(const bf16_t*)(ws + WS_R1), (const bf16_t*)(ws + WS_WGU + (size_t)f * SZ_WGU), T, 2 * FF, D}; pg8::StaticOrder So; So.init(T, 2 * FF, G, bid);
          EpiSwiGLU E{(bf16_t*)(ws + WS_R3)}; pg8::gemm_phase<EpiSwiGLU, pg8::StaticOrder, true, true>(lds, g, So, E); }
        GSYNC();
        { PHASE_IDS(); pg8::Gemm g{(const bf16_t*)(ws + WS_R3), (const bf16_t*)(ws + WS_WD + (size_t)f * SZ_WD), T, D, FF}; pg8::StaticOrder So; So.init(T, D, G, bid);
          EpiResidB<true, 0x7fffffff> E{(f == 0 ? ap->in[0] : (const float*)nullptr), Hb, Hb, nullptr}; pg8::gemm_phase<EpiResidB<true, 0x7fffffff>, pg8::StaticOrder, true, true>(lds, g, So, E); }
        GSYNC();
        if ((f & 1) == 0) {
            if (l < 2) {
                { PHASE_IDS(); pool_y_phase(Hb, ap->in[5] + l * D, (bf16_t*)(ws + WS_R3), (LAS float*)lds, bid, G, tid, lane, wave); }
                GSYNC();
                { PHASE_IDS(); pg8::Gemm g{(const bf16_t*)(ws + WS_R3), (const bf16_t*)(ws + WS_WP + (size_t)l * SZ_WP), 4 * T, D, 256}; PoolOrder So{G, bid};
                  EpiResidB<false, 127> E{nullptr, Hb, Hb, ap->in[11] + l * D}; pg8::gemm_phase<EpiResidB<false, 127>, PoolOrder, true, true>(lds, g, So, E); }
                GSYNC();
            } else {
                const int jj = l - 2;
                { PHASE_IDS(); norm_phase16(Hb, ap->in[5] + l * D, (bf16_t*)(ws + WS_R1), gw, NGW, lane); }
                GSYNC();
                { PHASE_IDS(); pg8::Gemm g{(const bf16_t*)(ws + WS_R1), (const bf16_t*)(ws + WS_WDQ + (size_t)jj * 524288), T, 256, D}; pg8::StaticOrder So; So.init(T, 256, G, bid);
                  EpiCQ E{(bf16_t*)(ws + WS_CQ), (float*)(ws + WS_SSQ) + (size_t)jj * T * 4}; pg8::gemm_phase<EpiCQ, pg8::StaticOrder, true, true>(lds, g, So, E); }
                GSYNC();
                { PHASE_IDS(); pg8::Gemm g{(const bf16_t*)(ws + WS_CQ), (const bf16_t*)(ws + WS_WUQ + (size_t)jj * SZ_WUQ), T, 2048, 256}; pg8::StaticOrder So; So.init(T, 2048, G, bid);
                  EpiQN E{(bf16_t*)(ws + WS_R3), (const float*)(ws + WS_SSQ) + (size_t)jj * T * 4}; pg8::gemm_phase<EpiQN, pg8::StaticOrder, true, true>(lds, g, So, E); }
                { PHASE_IDS(); pg8::Gemm g{(const bf16_t*)(ws + WS_CQ), (const bf16_t*)(ws + WS_WUQ + (size_t)jj * SZ_WUQ + (size_t)2048 * 256 * 2), T, 1024, 256}; pg8::StaticOrder So; So.init(T, 1024, G, bid);
                  EpiQR E{(bf16_t*)(ws + WS_R3), (const float*)(ws + WS_COS), (const float*)(ws + WS_SIN), (const float*)(ws + WS_SSQ) + (size_t)jj * T * 4}; pg8::gemm_phase<EpiQR, pg8::StaticOrder, true, true>(lds, g, So, E); }
                GSYNC();
                { PHASE_IDS(); attn_phase(lds, (const bf16_t*)(ws + WS_R3), ws + WS_KIMG, (bf16_t*)(ws + WS_R1), bid, G, tid, lane, wave); }
                GSYNC();
                { PHASE_IDS(); pg8::Gemm g{(const bf16_t*)(ws + WS_R1), (const bf16_t*)(ws + WS_WOV + (size_t)jj * SZ_WOV), T, D, 2048}; pg8::StaticOrder So; So.init(T, D, G, bid);
                  EpiResidB<false, 0x7fffffff> E{nullptr, Hb, Hb, nullptr}; pg8::gemm_phase<EpiResidB<false, 0x7fffffff>, pg8::StaticOrder, true, true>(lds, g, So, E); }
                GSYNC();
            }
            { PHASE_IDS(); norm_phase16(Hb, ap->in[6] + l * D, (bf16_t*)(ws + WS_R1), gw, NGW, lane); }
            GSYNC();
        } else {
            if (l == 1) {
                { PHASE_IDS(); norm_phase16(Hb, ap->in[12], (bf16_t*)(ws + WS_R1), gw, NGW, lane); }
                GSYNC();
                { PHASE_IDS(); pg8::Gemm g{(const bf16_t*)(ws + WS_R1), (const bf16_t*)(ws + WS_WDKV), T, 256, D}; pg8::StaticOrder So; So.init(T, 256, G, bid);
                  EpiF32 E{(float*)(ws + WS_RAW)}; pg8::gemm_phase<EpiF32, pg8::StaticOrder, true, true>(lds, g, So, E); }
                GSYNC();
                { PHASE_IDS(); kv_prep_phase((const float*)(ws + WS_RAW), ap->in[14], (const float*)(ws + WS_COS), (const float*)(ws + WS_SIN), ws + WS_KIMG, gw, NGW, lane); }
            }
            if (l < 3) { { PHASE_IDS(); norm_phase16(Hb, ap->in[1] + (l + 1) * D, (bf16_t*)(ws + WS_R1), gw, NGW, lane); } GSYNC(); }
        }
    }
    { PHASE_IDS();
      u32x4 fa[16], fb[16];
#pragma unroll
      for (int k = 0; k < 16; ++k) { const int m = gw + k * NGW; if (m < T) { fa[k] = *(const u32x4*)(Hb + (size_t)m * D + 8 * lane); fb[k] = *(const u32x4*)(Hb + (size_t)m * D + 512 + 8 * lane); } }
      GSYNC();
      const float* gain = ap->in[21];
      f32x4 g4[4];
      g4[0] = *(const f32x4*)(gain + 8 * lane); g4[1] = *(const f32x4*)(gain + 8 * lane + 4); g4[2] = *(const f32x4*)(gain + 512 + 8 * lane); g4[3] = *(const f32x4*)(gain + 512 + 8 * lane + 4);
#pragma unroll
      for (int k = 0; k < 16; ++k) { const int m = gw + k * NGW; if (m < T) {
          f32x4 v[4]; v[0] = bf_lo4(fa[k].x, fa[k].y); v[1] = bf_lo4(fa[k].z, fa[k].w); v[2] = bf_lo4(fb[k].x, fb[k].y); v[3] = bf_lo4(fb[k].z, fb[k].w);
          float sq = 0.f;
#pragma unroll
          for (int jx = 0; jx < 4; ++jx) sq += dot4(v[jx], v[jx]);
          const float rstd = 1.0f / sqrtf(wave_sum(sq) * (1.0f / D) + RMS_EPS);
          float* orow = Hout + (size_t)m * D;
          *(f32x4*)(orow + 8 * lane) = v[0] * rstd * g4[0]; *(f32x4*)(orow + 8 * lane + 4) = v[1] * rstd * g4[1];
          *(f32x4*)(orow + 512 + 8 * lane) = v[2] * rstd * g4[2]; *(f32x4*)(orow + 512 + 8 * lane + 4) = v[3] * rstd * g4[3]; } }
    }
}

extern "C" void kernel_launch(void* const* d_in, const int* in_sizes, int n_in, void* d_out, int out_size, void* d_ws, size_t ws_size, hipStream_t stream) {
    static int grid_blocks = 0;
    if (grid_blocks == 0) {
        if (n_in != 22 || out_size != T * D || ws_size < WS_END + 256 + 2 * (size_t)T * 16) { fprintf(stderr, "kernel_launch: unexpected shapes (n_in %d out %d ws %zu need %zu)\n", n_in, out_size, ws_size, (size_t)WS_END); grid_blocks = -1; return; }
        int dev = 0, cus = 0, per_cu = 0;
        hipGetDevice(&dev);
        hipDeviceGetAttribute(&cus, hipDeviceAttributeMultiprocessorCount, dev);
        if (hipFuncSetAttribute((const void*)yoco_fwd, hipFuncAttributeMaxDynamicSharedMemorySize, LDS_BYTES) != hipSuccess) { fprintf(stderr, "kernel_launch: hipFuncSetAttribute failed\n"); }
        hipOccupancyMaxActiveBlocksPerMultiprocessor(&per_cu, (const void*)yoco_fwd, NTHREADS, LDS_BYTES);
        if (per_cu < 1) { fprintf(stderr, "kernel_launch: occupancy query says %d blocks per CU\n", per_cu); per_cu = 1; }
        grid_blocks = cus;
        if ((long)cus * NWAVES * 16 < T) { fprintf(stderr, "kernel_launch: this build needs >= %d workgroups (final norm holds 16 rows per wave); device has %d CUs\n", T / (NWAVES * 16), cus); grid_blocks = -1; return; }
        (void)hipGetLastError();
    }
    if (grid_blocks < 0) return;
    if (hipMemsetAsync((unsigned char*)d_ws + WS_BAR, 0, 256, stream) != hipSuccess) { fprintf(stderr, "kernel_launch: memset of the barrier word failed\n"); return; }
    Args a{};
    for (int i = 0; i < 22; ++i) a.in[i] = (const float*)d_in[i];
    a.out = (float*)d_out; a.ws = (unsigned char*)d_ws;
    void* args[] = {&a};
    hipError_t e = hipLaunchCooperativeKernel((const void*)yoco_fwd, dim3(grid_blocks), dim3(NTHREADS), args, LDS_BYTES, stream);
    if (e != hipSuccess) fprintf(stderr, "cooperative launch failed: %s (grid %d)\n", hipGetErrorString(e), grid_blocks);
}
```
